# Optimizing an MI355X kernel written in HIP

```python
import math
import jax, jax.numpy as jnp
from jax import lax
import numpy as np

D_MODEL = 1024
BATCH = 16
SEQ = 4096
DEPTH = 2
DEC_BATCH = 8
DEC_SEQ = 4096
PAST_LEN = 128

N_MIXERS = 2
EXPAND = 2
D_INNER = EXPAND * D_MODEL
N_HEADS = 8
DA_HEAD_DIM = D_INNER // (2 * N_HEADS)
DA_V_DIM = 2 * DA_HEAD_DIM
DA_QK_WIDTH = 2 * N_HEADS * DA_HEAD_DIM
DA_IN = 2 * DA_QK_WIDTH + 2 * D_INNER
ROPE_THETA = 10000.0
Q_BLOCK = 128
RET_QK_DIM = D_MODEL // N_HEADS
RET_V_DIM = D_INNER // N_HEADS
RET_QK_WIDTH = N_HEADS * RET_QK_DIM
RET_IN = 2 * RET_QK_WIDTH + 2 * D_INNER
RET_CHUNK = 128
RET_ROT_BASE = 10000.0
N_ATTN_LAYERS = (DEPTH + 1) // 2
N_RET_LAYERS = DEPTH // 2
NORM_EPS = 1e-6
SUBLN_EPS = 1e-5

kernel_name = "diffattn_retnet_bidir_encoder"


def rms_norm(x, g, eps):
    xf = x.astype(jnp.float32)
    y = xf * lax.rsqrt(jnp.mean(xf * xf, axis=-1, keepdims=True) + eps)
    return (y * g.astype(jnp.float32)).astype(x.dtype)


def rotary_half(x):
    S, d = x.shape[1], x.shape[-1]
    inv = ROPE_THETA ** (-jnp.arange(0, d, 2, dtype=jnp.float32) / d)
    ang = jnp.arange(S, dtype=jnp.float32)[:, None] * inv[None, :]
    cos = jnp.cos(ang)[None, :, None, :].astype(x.dtype)
    sin = jnp.sin(ang)[None, :, None, :].astype(x.dtype)
    x1, x2 = x[..., : d // 2], x[..., d // 2:]
    return jnp.concatenate([x1 * cos - x2 * sin, x2 * cos + x1 * sin], axis=-1)


def retention_rotate(x):
    S, d = x.shape[1], x.shape[-1]
    angle = 1.0 / (RET_ROT_BASE ** jnp.linspace(0.0, 1.0, d // 2, dtype=jnp.float32))
    ang = jnp.arange(S, dtype=jnp.float32)[:, None] * angle[None, :]
    cos = jnp.cos(ang)[None, :, None, :].astype(x.dtype)
    sin = jnp.sin(ang)[None, :, None, :].astype(x.dtype)
    xp = x.reshape(*x.shape[:-1], d // 2, 2)
    x0, x1 = xp[..., 0], xp[..., 1]
    return jnp.stack([x0 * cos - x1 * sin, x1 * cos + x0 * sin], axis=-1).reshape(x.shape)


def diff_attention(h, w_in, lq1, lk1, lq2, lk2, subln_g, w_out, lambda_init):
    B, S, _ = h.shape
    proj = h @ w_in
    q, k, v, gate = jnp.split(proj, [DA_QK_WIDTH, 2 * DA_QK_WIDTH, 2 * DA_QK_WIDTH + D_INNER], axis=-1)
    q = rotary_half(q.reshape(B, S, 2 * N_HEADS, DA_HEAD_DIM)) * (DA_HEAD_DIM ** -0.5)
    k = rotary_half(k.reshape(B, S, 2 * N_HEADS, DA_HEAD_DIM))
    v = v.reshape(B, S, N_HEADS, DA_V_DIM)
    f32 = jnp.float32
    lam = (jnp.exp(jnp.sum(lq1.astype(f32) * lk1.astype(f32)))
           - jnp.exp(jnp.sum(lq2.astype(f32) * lk2.astype(f32))) + lambda_init)
    n_blk = S // Q_BLOCK
    q_blocks = q.reshape(B, n_blk, Q_BLOCK, 2 * N_HEADS, DA_HEAD_DIM).transpose(1, 0, 2, 3, 4)

    def block(qi):
        s = jnp.einsum('bqhd,bkhd->bhqk', qi, k).astype(f32)
        p = jax.nn.softmax(s, axis=-1).reshape(B, N_HEADS, 2, Q_BLOCK, S)
        a = (p[:, :, 0] - lam * p[:, :, 1]).astype(v.dtype)
        return jnp.einsum('bhqk,bkhe->bqhe', a, v)

    o = lax.map(block, q_blocks)
    o = o.transpose(1, 0, 2, 3, 4).reshape(B, S, N_HEADS, DA_V_DIM)
    o = rms_norm(o, subln_g, SUBLN_EPS) * (1.0 - lambda_init)
    o = o.reshape(B, S, D_INNER) * jax.nn.silu(gate)
    return o @ w_out


def retention_direction(q, k, v, log_g, include_diag):
    B, S, H, dk = q.shape
    dv = v.shape[-1]
    C = RET_CHUNK
    n_chunk = S // C
    dt = q.dtype
    idx = jnp.arange(C, dtype=jnp.float32)
    diff = idx[:, None] - idx[None, :]
    mask = (diff >= 0) if include_diag else (diff > 0)
    intra = jnp.where(mask[None], jnp.exp(jnp.where(mask, diff, 0.0)[None] * log_g[:, None, None]), 0.0).astype(dt)
    q_decay = jnp.exp((idx + 1.0)[:, None] * log_g[None, :]).astype(dt)
    k_decay = jnp.exp((C - 1.0 - idx)[:, None] * log_g[None, :]).astype(dt)
    chunk_decay = jnp.exp(C * log_g).astype(dt)

    def to_chunks(t):
        return t.reshape(B, n_chunk, C, H, t.shape[-1]).transpose(1, 0, 2, 3, 4)

    def step(state, inp):
        qc, kc, vc = inp
        scores = jnp.einsum('bqhd,bkhd->bhqk', qc, kc) * intra[None]
        o = (jnp.einsum('bhqk,bkhe->bqhe', scores, vc)
             + jnp.einsum('bqhd,bhde->bqhe', qc * q_decay[None, :, :, None], state))
        state = (state * chunk_decay[None, :, None, None]
                 + jnp.einsum('bkhd,bkhe->bhde', kc * k_decay[None, :, :, None], vc))
        return state, o

    state0 = jnp.zeros((B, H, dk, dv), dt)
    _, o = lax.scan(step, state0, (to_chunks(q), to_chunks(k), to_chunks(v)))
    return o.transpose(1, 0, 2, 3, 4).reshape(B, S, H, dv)


def bidir_retention(h, w_in, decay_fwd, decay_bwd, subln_g, w_out):
    B, S, _ = h.shape
    proj = h @ w_in
    q, k, v, gate = jnp.split(proj, [RET_QK_WIDTH, 2 * RET_QK_WIDTH, 2 * RET_QK_WIDTH + D_INNER], axis=-1)
    q = retention_rotate(q.reshape(B, S, N_HEADS, RET_QK_DIM))
    k = retention_rotate(k.reshape(B, S, N_HEADS, RET_QK_DIM)) * (RET_QK_DIM ** -0.5)
    v = v.reshape(B, S, N_HEADS, RET_V_DIM)
    log_g_f = -jnp.exp(decay_fwd.astype(jnp.float32))
    log_g_b = -jnp.exp(decay_bwd.astype(jnp.float32))
    o_f = retention_direction(q, k, v, log_g_f, True)
    o_b = jnp.flip(retention_direction(jnp.flip(q, 1), jnp.flip(k, 1), jnp.flip(v, 1), log_g_b, False), 1)
    o = rms_norm(o_f + o_b, subln_g, SUBLN_EPS)
    o = o.reshape(B, S, D_INNER) * jax.nn.silu(gate)
    return o @ w_out


def trunk(x, norm_g, da_w_in, da_lambda_q1, da_lambda_k1, da_lambda_q2, da_lambda_k2,
          da_subln_g, da_w_out, ret_w_in, ret_decay_fwd, ret_decay_bwd, ret_subln_g,
          ret_w_out, final_norm_g):
    for i in range(DEPTH):
        h = rms_norm(x, norm_g[i], NORM_EPS)
        j = i // N_MIXERS
        if i % N_MIXERS == 0:
            lambda_init = 0.8 - 0.6 * math.exp(-0.3 * i)
            x = x + diff_attention(h, da_w_in[j], da_lambda_q1[j], da_lambda_k1[j], da_lambda_q2[j],
                                   da_lambda_k2[j], da_subln_g[j], da_w_out[j], lambda_init)
        else:
            x = x + bidir_retention(h, ret_w_in[j], ret_decay_fwd[j], ret_decay_bwd[j],
                                    ret_subln_g[j], ret_w_out[j])
    return rms_norm(x, final_norm_g, NORM_EPS)


def setup_inputs(seed: int = 0) -> dict:
    key = jax.random.key(seed)
    ks = jax.random.split(key, 16)
    f32 = jnp.float32
    base_decay = jnp.log(-jnp.log1p(-(2.0 ** (-5.0 - jnp.arange(N_HEADS, dtype=f32)))))
    return {
        "x_prompt": jax.random.normal(ks[0], (BATCH, SEQ, D_MODEL), f32),
        "x_sample": jax.random.normal(ks[1], (DEC_BATCH, DEC_SEQ, D_MODEL), f32),
        "norm_g": 1.0 + 0.02 * jax.random.normal(ks[2], (DEPTH, D_MODEL), f32),
        "da_w_in": jax.random.normal(ks[3], (N_ATTN_LAYERS, D_MODEL, DA_IN), f32) * D_MODEL ** -0.5,
        "da_lambda_q1": 0.1 * jax.random.normal(ks[4], (N_ATTN_LAYERS, DA_HEAD_DIM), f32),
        "da_lambda_k1": 0.1 * jax.random.normal(ks[5], (N_ATTN_LAYERS, DA_HEAD_DIM), f32),
        "da_lambda_q2": 0.1 * jax.random.normal(ks[6], (N_ATTN_LAYERS, DA_HEAD_DIM), f32),
        "da_lambda_k2": 0.1 * jax.random.normal(ks[7], (N_ATTN_LAYERS, DA_HEAD_DIM), f32),
        "da_subln_g": 1.0 + 0.02 * jax.random.normal(ks[8], (N_ATTN_LAYERS, DA_V_DIM), f32),
        "da_w_out": jax.random.normal(ks[9], (N_ATTN_LAYERS, D_INNER, D_MODEL), f32) * D_INNER ** -0.5,
        "ret_w_in": jax.random.normal(ks[10], (N_RET_LAYERS, D_MODEL, RET_IN), f32) * D_MODEL ** -0.5,
        "ret_decay_fwd": base_decay[None] + 0.1 * jax.random.normal(ks[11], (N_RET_LAYERS, N_HEADS), f32),
        "ret_decay_bwd": base_decay[None] + 0.1 * jax.random.normal(ks[12], (N_RET_LAYERS, N_HEADS), f32),
        "ret_subln_g": 1.0 + 0.02 * jax.random.normal(ks[13], (N_RET_LAYERS, RET_V_DIM), f32),
        "ret_w_out": jax.random.normal(ks[14], (N_RET_LAYERS, D_INNER, D_MODEL), f32) * D_INNER ** -0.5,
        "final_norm_g": 1.0 + 0.02 * jax.random.normal(ks[15], (D_MODEL,), f32),
    }


def reference(x_prompt, x_sample, norm_g, da_w_in, da_lambda_q1, da_lambda_k1, da_lambda_q2,
              da_lambda_k2, da_subln_g, da_w_out, ret_w_in, ret_decay_fwd, ret_decay_bwd,
              ret_subln_g, ret_w_out, final_norm_g):
    y_prompt = trunk(x_prompt, norm_g, da_w_in, da_lambda_q1, da_lambda_k1, da_lambda_q2, da_lambda_k2,
                     da_subln_g, da_w_out, ret_w_in, ret_decay_fwd, ret_decay_bwd, ret_subln_g,
                     ret_w_out, final_norm_g)
    y_sample = trunk(x_sample, norm_g, da_w_in, da_lambda_q1, da_lambda_k1, da_lambda_q2, da_lambda_k2,
                     da_subln_g, da_w_out, ret_w_in, ret_decay_fwd, ret_decay_bwd, ret_subln_g,
                     ret_w_out, final_norm_g)
    return (y_prompt, y_sample)
```

```cpp
#include <hip/hip_runtime.h>
#include <hip/hip_cooperative_groups.h>
#include <cstdio>
namespace cg = cooperative_groups;
__device__ __forceinline__ int mk_opaque_tid() { int t = threadIdx.x; asm volatile("" : "+v"(t)); return t; }
namespace pg8 {
#define PG8_LAS __attribute__((address_space(3)))
typedef unsigned short bf16_t;
typedef short bf16x8 __attribute__((ext_vector_type(8)));
typedef float f32x4 __attribute__((ext_vector_type(4)));
typedef unsigned u32x4 __attribute__((ext_vector_type(4)));
constexpr int BM = 256, BK = 64, HALF = 128, HTB = HALF * BK * 2  , STAGE_BYTES = 8 * HTB, NXCD = 8, WGM = 8;

__host__ __device__ __forceinline__ int lds_byte(int r, int c) { const int st = (r >> 4) * 2 + (c >> 5), rr = r & 15, cc = c & 31, ob = rr * 64 + cc * 2; return st * 1024 + (ob ^ (((ob >> 9) & 1) << 5)); }
__host__ __device__ __forceinline__ void stage_rc(int b, int& R, int& C) { const int st = b / 1024, sb = b % 1024, swz = sb ^ (((sb >> 9) & 1) << 5); R = (st >> 1) * 16 + swz / 64; C = (st & 1) * 32 + (swz % 64) / 2; }
__host__ __device__ __forceinline__ int perm32(int rho) { const int n = rho >> 4, i = rho & 15; return 8 * (i >> 2) + 4 * n + (i & 3); }

struct Unit { int pm, pn; };
struct Gemm { const bf16_t* A; const bf16_t* Bt; int M, N, K; };

struct StaticOrder {
    int nM, nN, nwg, G, c;
    __host__ __device__ void init(int M, int N, int G_, int c_) { nM = M / BM; nN = N / BM; nwg = nM * nN; G = G_; c = c_; }
    __host__ __device__ bool next(int i, Unit& u) const {
        const long L = (long)i * G + c; if (L >= nwg) return false;
        int wgid = (int)L; { const int q = nwg / NXCD, r = nwg % NXCD, xcd = wgid % NXCD, off = wgid / NXCD; wgid = (xcd < r ? xcd * (q + 1) : r * (q + 1) + (xcd - r) * q) + off; }
        const int nig = WGM * nN, gid = wgid / nig, fm = gid * WGM, gsz = (nM - fm) < WGM ? (nM - fm) : WGM;
        u.pm = fm + ((wgid % nig) % gsz); u.pn = (wgid % nig) / gsz; return true;
    }
    __device__ __forceinline__ void a_ready(const Unit&) const {}
    __device__ __forceinline__ void done(const Unit&) const {}
};
__device__ __forceinline__ unsigned cvt_pk_bf16(float lo, float hi) { unsigned r; asm volatile("v_cvt_pk_bf16_f32 %0, %1, %2" : "=v"(r) : "v"(lo), "v"(hi)); return r; }
template <class Epi, class Sched, bool STAMP = false>
__device__ __forceinline__ void gemm_phase(PG8_LAS unsigned char* lds, const Gemm g, const Sched& S, const Epi& E, unsigned long long* stamps) {
    const int tid = mk_opaque_tid(), wid = __builtin_amdgcn_readfirstlane(tid >> 6), lane = tid & 63, wr = wid >> 2, wc = wid & 3, fr = lane & 15, fq = lane >> 4;
    const int K = g.K, nt = K / BK;
    int ts_lo = 0, ts_hi = 0, nts = 0; const unsigned long long rt_entry = STAMP ? (unsigned long long)wall_clock64() : 0ull;
#define PG8_STAMP() do { if (STAMP && wid == 0 && nts < 64) { const unsigned long long _c = (unsigned long long)clock64(); \
        ts_lo = (lane == nts) ? (int)(unsigned)_c : ts_lo; ts_hi = (lane == nts) ? (int)(unsigned)(_c >> 32) : ts_hi; ++nts; } } while (0)
    PG8_STAMP();
    unsigned voffA[2], voffB[2];
#pragma unroll
    for (int i = 0; i < 2; ++i) { int R, C; stage_rc(tid * 16 + i * 8192, R, C); const int Rb = Epi::PERM ? ((R & ~31) + perm32(R & 31)) : R;
        voffA[i] = (unsigned)(R * K + C) * 2u; voffB[i] = (unsigned)(Rb * K + C) * 2u; }
    const size_t kstep = (size_t)(BK * 2);
    const size_t hstep = (size_t)HALF * K * 2;
    const size_t tstep = 2 * hstep;
    const unsigned ldsw = (unsigned)wid * 1024u;
    const int aoff = lds_byte(wr * 64 + fr, fq * 8), boff = lds_byte(wc * 32 + fr, fq * 8);
#define PG8_SA(b, h) (((b) * 2 + (h)) * HTB)
#define PG8_SB(b, h) ((4 + (b) * 2 + (h)) * HTB)
#define PG8_STAGE(bufoff, gbase, voff) do { _Pragma("unroll") for (int _i = 0; _i < 2; ++_i) \
        __builtin_amdgcn_global_load_lds((const unsigned*)((const char*)(gbase) + (voff)[_i]), (PG8_LAS unsigned*)(lds + (bufoff) + ldsw + _i * 8192), 16, 0, 0); } while (0)
#define PG8_LDA(dst, b, h) do { _Pragma("unroll") for (int m = 0; m < 4; ++m) _Pragma("unroll") for (int k = 0; k < 2; ++k) dst[m][k] = *(const PG8_LAS bf16x8*)(lds + PG8_SA(b, h) + aoff + m * 2048 + k * 1024); } while (0)
#define PG8_LDB(dst, b, h) do { _Pragma("unroll") for (int n = 0; n < 2; ++n) _Pragma("unroll") for (int k = 0; k < 2; ++k) dst[n][k] = *(const PG8_LAS bf16x8*)(lds + PG8_SB(b, h) + boff + n * 2048 + k * 1024); } while (0)
#define PG8_MMA(ai, bj, At, Bt) do { __builtin_amdgcn_s_setprio(1); _Pragma("unroll") for (int m = 0; m < 4; ++m) _Pragma("unroll") for (int n = 0; n < 2; ++n) _Pragma("unroll") for (int k = 0; k < 2; ++k) \
        acc[ai][bj][m][n] = __builtin_amdgcn_mfma_f32_16x16x32_bf16(Bt[n][k], At[m][k], acc[ai][bj][m][n], 0, 0, 0); __builtin_amdgcn_s_setprio(0); } while (0)
#define PG8_WAIT_V(n) asm volatile("s_waitcnt vmcnt(" #n ")" ::: "memory")
#define PG8_WAIT_L(n) asm volatile("s_waitcnt lgkmcnt(" #n ")" ::: "memory")
#define PG8_BAR __builtin_amdgcn_s_barrier()
#define PG8_SCHED __builtin_amdgcn_sched_barrier(0)
    Unit cur, nxt; int ui = 0;
    if (!S.next(0, cur)) return;
    f32x4 acc[2][2][4][2];
#pragma unroll
    for (int a = 0; a < 2; ++a)
#pragma unroll
        for (int b = 0; b < 2; ++b)
#pragma unroll
            for (int m = 0; m < 4; ++m)
#pragma unroll
                for (int n = 0; n < 2; ++n) acc[a][b][m][n] = (f32x4){0.f, 0.f, 0.f, 0.f};
    bf16x8 At[4][2], B0[2][2], B1[2][2];
    const char* cA = (const char*)g.A + (size_t)cur.pm * tstep; const char* cB = (const char*)g.Bt + (size_t)cur.pn * tstep;
    S.a_ready(cur);
    PG8_STAGE(PG8_SB(0, 0), cB, voffB); PG8_STAGE(PG8_SA(0, 0), cA, voffA); PG8_STAGE(PG8_SB(0, 1), cB + hstep, voffB); PG8_STAGE(PG8_SA(0, 1), cA + hstep, voffA);
    if (wr == 1) PG8_BAR;
    PG8_WAIT_V(4); PG8_BAR;
    PG8_STAGE(PG8_SB(1, 0), cB + kstep, voffB); PG8_STAGE(PG8_SA(1, 0), cA + kstep, voffA); PG8_STAGE(PG8_SB(1, 1), cB + hstep + kstep, voffB);
    PG8_WAIT_V(6); PG8_BAR;
    PG8_STAMP();
    for (;;) {
        const bool has_next = S.next(ui + 1, nxt);
        const char* nA = has_next ? (const char*)g.A + (size_t)nxt.pm * tstep : cA; const char* nB = has_next ? (const char*)g.Bt + (size_t)nxt.pn * tstep : cB;
        for (int t = 0; t < nt; t += 2) {
            const bool last = (t == nt - 2);
            const char* a1 = cA + (size_t)(t + 1) * kstep;
            const char* a2 = last ? nA : cA + (size_t)(t + 2) * kstep; const char* b2 = last ? nB : cB + (size_t)(t + 2) * kstep;
            const char* a3 = a2 + kstep; const char* b3 = b2 + kstep;
            if (last && has_next) S.a_ready(nxt);
            PG8_LDB(B0, 0, 0); PG8_SCHED; PG8_LDA(At, 0, 0); PG8_STAGE(PG8_SA(1, 1), a1 + hstep, voffA);
            PG8_WAIT_L(8); PG8_BAR; PG8_WAIT_L(0); PG8_MMA(0, 0, At, B0); PG8_BAR; PG8_SCHED;
            PG8_LDB(B1, 0, 1); PG8_STAGE(PG8_SB(0, 0), b2, voffB);
            PG8_BAR; PG8_WAIT_L(0); PG8_MMA(0, 1, At, B1); PG8_BAR;
            PG8_LDA(At, 0, 1); PG8_STAGE(PG8_SA(0, 0), a2, voffA);
            PG8_BAR; PG8_WAIT_L(0); PG8_MMA(1, 0, At, B0); PG8_BAR; PG8_SCHED;
            PG8_STAGE(PG8_SB(0, 1), b2 + hstep, voffB);
            PG8_WAIT_V(6); PG8_BAR; PG8_MMA(1, 1, At, B1); PG8_BAR;
            PG8_LDB(B0, 1, 0); PG8_SCHED; PG8_LDA(At, 1, 0); PG8_STAGE(PG8_SA(0, 1), a2 + hstep, voffA);
            PG8_WAIT_L(8); PG8_BAR; PG8_WAIT_L(0); PG8_MMA(0, 0, At, B0); PG8_BAR; PG8_SCHED;
            PG8_LDB(B1, 1, 1); PG8_STAGE(PG8_SB(1, 0), b3, voffB);
            PG8_BAR; PG8_WAIT_L(0); PG8_MMA(0, 1, At, B1); PG8_BAR;
            PG8_LDA(At, 1, 1); PG8_STAGE(PG8_SA(1, 0), a3, voffA);
            PG8_BAR; PG8_WAIT_L(0); PG8_MMA(1, 0, At, B0); PG8_BAR; PG8_SCHED;
            PG8_STAGE(PG8_SB(1, 1), b3 + hstep, voffB);
            PG8_WAIT_V(6); PG8_BAR; PG8_MMA(1, 1, At, B1); PG8_BAR;
        }
        PG8_STAMP();
        if constexpr (!Epi::AFTER_DRAIN) { E(acc, cur, wr, wc, fr, fq); S.done(cur); }
        PG8_STAMP();
        if (!has_next) break;
#pragma unroll
        for (int a = 0; a < 2; ++a)
#pragma unroll
            for (int b = 0; b < 2; ++b)
#pragma unroll
                for (int m = 0; m < 4; ++m)
#pragma unroll
                    for (int n = 0; n < 2; ++n) acc[a][b][m][n] = (f32x4){0.f, 0.f, 0.f, 0.f};
        cur = nxt; cA = nA; cB = nB; ++ui;
    }
    PG8_WAIT_V(0);
    if (wr == 0) PG8_BAR;
    PG8_BAR;
    if constexpr (Epi::AFTER_DRAIN) { E.fused(acc, cur, wr, wc, fr, fq, lds, wid, lane); S.done(cur); }
    PG8_STAMP();
    if (STAMP && wid == 0) { stamps[lane] = lane < nts ? (((unsigned long long)(unsigned)ts_hi << 32) | (unsigned)ts_lo) : 0ull;
        if (lane == 62) stamps[62] = rt_entry; if (lane == 63) stamps[63] = (unsigned long long)wall_clock64(); }
#undef PG8_STAMP
#undef PG8_SA
#undef PG8_SB
#undef PG8_STAGE
#undef PG8_LDA
#undef PG8_LDB
#undef PG8_MMA
#undef PG8_WAIT_V
#undef PG8_WAIT_L
#undef PG8_BAR
#undef PG8_SCHED
}
}

namespace mk {
using pg8::bf16_t; using pg8::bf16x8; using pg8::f32x4; using pg8::u32x4; using pg8::Unit; using pg8::Gemm; using pg8::StaticOrder; using pg8::cvt_pk_bf16;
typedef short s16x4 __attribute__((ext_vector_type(4)));
typedef float f32x16 __attribute__((ext_vector_type(16)));
#define LAS __attribute__((address_space(3)))

constexpr int SEQ = 4096, DM = 1024, DI = 2048, GSEQ = 8, MR = GSEQ * SEQ, NROUND = 3;
constexpr size_t LDS_BYTES = 136 * 1024;
constexpr size_t OFF_WIN_DA = 0, OFF_WOUT_DA = OFF_WIN_DA + (size_t)8192 * 1024 * 2, OFF_WIN_RET = OFF_WOUT_DA + (size_t)1024 * 2048 * 2,
                 OFF_WOUT_RET = OFF_WIN_RET + (size_t)6144 * 1024 * 2, OFF_TAB = OFF_WOUT_RET + (size_t)1024 * 2048 * 2,
                 OFF_H = OFF_TAB + (size_t)4 * 4096 * 64 * 4, OFF_BIG = OFF_H + (size_t)MR * DM * 2;
constexpr size_t SZ_2048 = (size_t)MR * 2048 * 2, SZ_1024 = (size_t)MR * 1024 * 2;
constexpr size_t OFF_RQ = OFF_BIG, OFF_RK = OFF_RQ + SZ_1024, OFF_RV = OFF_RK + SZ_1024, OFF_RG = OFF_RV + SZ_2048, OFF_SF = OFF_RG + SZ_2048, OFF_SB = OFF_SF + SZ_2048;

struct Params {
    const float* x_prompt; const float* x_sample; const float* norm_g; const float* da_w_in; const float* lq1; const float* lk1; const float* lq2; const float* lk2;
    const float* da_subln_g; const float* da_w_out; const float* ret_w_in; const float* ret_decay_fwd; const float* ret_decay_bwd; const float* ret_subln_g;
    const float* ret_w_out; const float* final_norm_g; float* out; unsigned char* ws;
};

__device__ __forceinline__ unsigned short f2bf(float f) { unsigned u = __float_as_uint(f); u += 0x7FFFu + ((u >> 16) & 1u); return (unsigned short)(u >> 16); }
__device__ __forceinline__ float bflo(unsigned w) { return __uint_as_float(w << 16); }
__device__ __forceinline__ float bfhi(unsigned w) { return __uint_as_float(w & 0xffff0000u); }
__device__ __forceinline__ bf16x8 scale8(bf16x8 x, float f) {
    u32x4 w = *reinterpret_cast<u32x4*>(&x); u32x4 r;
    r.x = cvt_pk_bf16(bflo(w.x) * f, bfhi(w.x) * f); r.y = cvt_pk_bf16(bflo(w.y) * f, bfhi(w.y) * f);
    r.z = cvt_pk_bf16(bflo(w.z) * f, bfhi(w.z) * f); r.w = cvt_pk_bf16(bflo(w.w) * f, bfhi(w.w) * f);
    return *reinterpret_cast<bf16x8*>(&r);
}
#define MK_BAR() do { asm volatile("" ::: "memory"); __builtin_amdgcn_s_barrier(); asm volatile("" ::: "memory"); } while (0)
#define SBAR() __builtin_amdgcn_sched_barrier(0)
#define KSWZ(row, colB) ((row) * 256 + ((colB) ^ (((row) & 7) << 4)))
__device__ __forceinline__ int crow(int r, int hi) { return (r & 3) + 8 * (r >> 2) + 4 * hi; }
template <int NCG> __device__ __forceinline__ int v_st(int k, int c) { const int kk = (k & ~0xC) | ((k & 4) << 1) | ((k & 8) >> 1); return ((kk >> 3) * NCG + (c >> 5)) * 512 + ((kk & 7) * 32 + (c & 31)) * 2; }
__device__ __forceinline__ int v_rd_base(int lane) { return ((lane & 3) << 3) | (((lane >> 2) & 3) << 6) | (((lane >> 4) & 1) << 5) | (((lane >> 5) & 1) << 8); }
template <int OFF> __device__ __forceinline__ s16x4 tr_read(unsigned vb) {
    s16x4 r; asm volatile("ds_read_b64_tr_b16 %0, %1 offset:%2" : "=&v"(r) : "v"(vb), "i"(OFF) : "memory"); return r;
}
#define PKLH(L, H) (bf16x8){L[0], L[1], L[2], L[3], H[0], H[1], H[2], H[3]}
#define PK4(P, BASE, OUT) do { unsigned a0 = cvt_pk_bf16(P[BASE + 0], P[BASE + 1]), a1 = cvt_pk_bf16(P[BASE + 2], P[BASE + 3]);   \
    unsigned b0 = cvt_pk_bf16(P[BASE + 4], P[BASE + 5]), b1 = cvt_pk_bf16(P[BASE + 6], P[BASE + 7]);                              \
    auto r0 = __builtin_amdgcn_permlane32_swap(a0, b0, false, false); auto r1 = __builtin_amdgcn_permlane32_swap(a1, b1, false, false); \
    u32x4 w_ = {r0[0], r1[0], r0[1], r1[1]}; OUT = *reinterpret_cast<bf16x8*>(&w_); } while (0)

__device__ __forceinline__ void transpose_tile(const float* __restrict__ W, bf16_t* __restrict__ Wt, int K, int N, bool permDA, int tile, LAS float* t) {
    const int ntn = N / 64, kt = tile / ntn, nt = tile % ntn, k0 = kt * 64, n0 = nt * 64, tid = mk_opaque_tid();
#pragma unroll
    for (int i = 0; i < 8; ++i) { const int k = i * 8 + (tid >> 6), n = tid & 63; t[k * 65 + n] = W[(size_t)(k0 + k) * N + n0 + n]; }
    __syncthreads();
#pragma unroll
    for (int i = 0; i < 8; ++i) { const int n = i * 8 + (tid >> 6), k = tid & 63; const int ns = n0 + n; int nd = ns;
        if (permDA && ns < 4096) { const int d = ns & 127; nd = (ns & ~127) + (d < 64 ? 2 * d : 2 * (d - 64) + 1); }
        Wt[(size_t)nd * K + k0 + k] = f2bf(t[k * 65 + n]); }
    __syncthreads();
}
__device__ __forceinline__ void prep_phase(const Params& P, LAS unsigned char* lds) {
    LAS float* t = (LAS float*)lds;
    bf16_t* w0 = (bf16_t*)(P.ws + OFF_WIN_DA); bf16_t* w1 = (bf16_t*)(P.ws + OFF_WOUT_DA); bf16_t* w2 = (bf16_t*)(P.ws + OFF_WIN_RET); bf16_t* w3 = (bf16_t*)(P.ws + OFF_WOUT_RET);
    constexpr int T0 = 16 * 128, T1 = 32 * 16, T2 = 16 * 96, T3 = 32 * 16;
    for (int i = blockIdx.x; i < T0 + T1 + T2 + T3; i += gridDim.x) {
        if (i < T0) transpose_tile(P.da_w_in, w0, 1024, 8192, true, i, t);
        else if (i < T0 + T1) transpose_tile(P.da_w_out, w1, 2048, 1024, false, i - T0, t);
        else if (i < T0 + T1 + T2) transpose_tile(P.ret_w_in, w2, 1024, 6144, false, i - T0 - T1, t);
        else transpose_tile(P.ret_w_out, w3, 2048, 1024, false, i - T0 - T1 - T2, t);
    }
    float* tab = (float*)(P.ws + OFF_TAB);
    for (int idx = blockIdx.x * 512 + threadIdx.x; idx < 2 * 4096 * 64; idx += gridDim.x * 512) {
        const int which = idx >> 18, e = idx & 262143, pos = e >> 6, i = e & 63;
        const double ex = which ? (double)i / 63.0 : (double)i / 64.0;
        const float inv = (float)exp(-ex * 9.210340371976184);
        const float ang = (float)pos * inv;
        double rev = (double)ang * 0.15915494309189535; rev -= rint(rev);
        const float rr = (float)(rev * 6.283185307179586);
        tab[(size_t)(which * 2) * 262144 + e] = __cosf(rr); tab[(size_t)(which * 2 + 1) * 262144 + e] = __sinf(rr);
    }
}

__device__ __forceinline__ void norm_to_bf16(const float* __restrict__ X, const float* __restrict__ g, bf16_t* __restrict__ H, int rows) {
    const int tid_ = mk_opaque_tid(), lane = tid_ & 63, gw = blockIdx.x * 8 + (tid_ >> 6), nw = gridDim.x * 8;
    f32x4 gv[4];
#pragma unroll
    for (int j = 0; j < 4; ++j) gv[j] = *(const f32x4*)(g + j * 256 + lane * 4);
    for (int r = gw; r < rows; r += nw) {
        const float* xr = X + (size_t)r * DM; f32x4 v[4]; float ss = 0.f;
#pragma unroll
        for (int j = 0; j < 4; ++j) { v[j] = *(const f32x4*)(xr + j * 256 + lane * 4); ss += v[j][0] * v[j][0] + v[j][1] * v[j][1] + v[j][2] * v[j][2] + v[j][3] * v[j][3]; }
#pragma unroll
        for (int o = 32; o >= 1; o >>= 1) ss += __shfl_xor(ss, o);
        const float rs = rsqrtf(ss * (1.0f / DM) + 1e-6f);
#pragma unroll
        for (int j = 0; j < 4; ++j) { uint2 w; w.x = cvt_pk_bf16(v[j][0] * rs * gv[j][0], v[j][1] * rs * gv[j][1]); w.y = cvt_pk_bf16(v[j][2] * rs * gv[j][2], v[j][3] * rs * gv[j][3]);
            *(uint2*)(H + (size_t)r * DM + j * 256 + lane * 4) = w; }
    }
}
__device__ __forceinline__ void norm_inplace_f32(float* __restrict__ X, const float* __restrict__ g, int rows) {
    const int tid_ = mk_opaque_tid(), lane = tid_ & 63, gw = blockIdx.x * 8 + (tid_ >> 6), nw = gridDim.x * 8;
    f32x4 gv[4];
#pragma unroll
    for (int j = 0; j < 4; ++j) gv[j] = *(const f32x4*)(g + j * 256 + lane * 4);
    for (int r = gw; r < rows; r += nw) {
        float* xr = X + (size_t)r * DM; f32x4 v[4]; float ss = 0.f;
#pragma unroll
        for (int j = 0; j < 4; ++j) { v[j] = *(const f32x4*)(xr + j * 256 + lane * 4); ss += v[j][0] * v[j][0] + v[j][1] * v[j][1] + v[j][2] * v[j][2] + v[j][3] * v[j][3]; }
#pragma unroll
        for (int o = 32; o >= 1; o >>= 1) ss += __shfl_xor(ss, o);
        const float rs = rsqrtf(ss * (1.0f / DM) + 1e-6f);
#pragma unroll
        for (int j = 0; j < 4; ++j) { f32x4 y = {v[j][0] * rs * gv[j][0], v[j][1] * rs * gv[j][1], v[j][2] * rs * gv[j][2], v[j][3] * rs * gv[j][3]}; *(f32x4*)(xr + j * 256 + lane * 4) = y; }
    }
}

__device__ __forceinline__ u32x4 rot_pack(f32x4 v0, f32x4 v1, const float* tc, const float* ts, float sc) {
    const f32x4 c = *(const f32x4*)tc, s = *(const f32x4*)ts; u32x4 w;
    w.x = cvt_pk_bf16((v0[0] * c[0] - v0[1] * s[0]) * sc, (v0[1] * c[0] + v0[0] * s[0]) * sc);
    w.y = cvt_pk_bf16((v0[2] * c[1] - v0[3] * s[1]) * sc, (v0[3] * c[1] + v0[2] * s[1]) * sc);
    w.z = cvt_pk_bf16((v1[0] * c[2] - v1[1] * s[2]) * sc, (v1[1] * c[2] + v1[0] * s[2]) * sc);
    w.w = cvt_pk_bf16((v1[2] * c[3] - v1[3] * s[3]) * sc, (v1[3] * c[3] + v1[2] * s[3]) * sc);
    return w;
}
__device__ __forceinline__ u32x4 plain_pack(f32x4 v0, f32x4 v1) { u32x4 w; w.x = cvt_pk_bf16(v0[0], v0[1]); w.y = cvt_pk_bf16(v0[2], v0[3]); w.z = cvt_pk_bf16(v1[0], v1[1]); w.w = cvt_pk_bf16(v1[2], v1[3]); return w; }

struct EpiDA {
    static constexpr bool PERM = true, AFTER_DRAIN = false;
    bf16_t* big; const float* tcos; const float* tsin;
    __device__ __forceinline__ void operator()(const f32x4 (&acc)[2][2][4][2], const Unit& u, int wr, int wc, int fr, int fq) const {
        const int region = u.pn >> 3; bf16_t* base = big + (size_t)region * ((size_t)MR * 2048);
        const int colr0 = (u.pn & 7) * 256 + wc * 32 + 8 * fq, row0 = u.pm * 256 + wr * 64 + fr;
        const float sc = region == 0 ? 0.08838834764831845f : 1.0f;
#pragma unroll
        for (int ai = 0; ai < 2; ++ai)
#pragma unroll
            for (int m = 0; m < 4; ++m) { const int row = row0 + ai * 128 + m * 16, pos = row & (SEQ - 1);
#pragma unroll
                for (int bj = 0; bj < 2; ++bj) { const int colr = colr0 + bj * 128; u32x4 w;
                    if (region < 2) { const int i0 = (colr & 127) >> 1; w = rot_pack(acc[ai][bj][m][0], acc[ai][bj][m][1], tcos + pos * 64 + i0, tsin + pos * 64 + i0, sc); }
                    else w = plain_pack(acc[ai][bj][m][0], acc[ai][bj][m][1]);
                    *(u32x4*)(base + (size_t)row * 2048 + colr) = w; } }
    }
};
struct EpiRET {
    static constexpr bool PERM = true, AFTER_DRAIN = false;
    bf16_t* rq; bf16_t* rk; bf16_t* rv; bf16_t* rg; const float* tcos; const float* tsin;
    __device__ __forceinline__ void operator()(const f32x4 (&acc)[2][2][4][2], const Unit& u, int wr, int wc, int fr, int fq) const {
        const bool isrot = u.pn < 8; bf16_t* base; int ld, colt;
        if (u.pn < 4) { base = rq; ld = 1024; colt = u.pn * 256; } else if (u.pn < 8) { base = rk; ld = 1024; colt = (u.pn - 4) * 256; }
        else if (u.pn < 16) { base = rv; ld = 2048; colt = (u.pn - 8) * 256; } else { base = rg; ld = 2048; colt = (u.pn - 16) * 256; }
        const int colr0 = colt + wc * 32 + 8 * fq, row0 = u.pm * 256 + wr * 64 + fr;
        const float sc = (u.pn >= 4 && u.pn < 8) ? 0.08838834764831845f : 1.0f;
#pragma unroll
        for (int ai = 0; ai < 2; ++ai)
#pragma unroll
            for (int m = 0; m < 4; ++m) { const int row = row0 + ai * 128 + m * 16, pos = row & (SEQ - 1);
#pragma unroll
                for (int bj = 0; bj < 2; ++bj) { const int colr = colr0 + bj * 128; u32x4 w;
                    if (isrot) { const int i0 = (colr & 127) >> 1; w = rot_pack(acc[ai][bj][m][0], acc[ai][bj][m][1], tcos + pos * 64 + i0, tsin + pos * 64 + i0, sc); }
                    else w = plain_pack(acc[ai][bj][m][0], acc[ai][bj][m][1]);
                    *(u32x4*)(base + (size_t)row * ld + colr) = w; } }
    }
};
struct EpiRes {
    static constexpr bool PERM = false, AFTER_DRAIN = false;
    float* out; const float* res;
    __device__ __forceinline__ void operator()(const f32x4 (&acc)[2][2][4][2], const Unit& u, int wr, int wc, int fr, int fq) const {
        const int row0 = u.pm * 256 + wr * 64 + fr, col0 = u.pn * 256 + wc * 32 + 4 * fq;
#pragma unroll
        for (int ai = 0; ai < 2; ++ai)
#pragma unroll
            for (int m = 0; m < 4; ++m) { const size_t ro = (size_t)(row0 + ai * 128 + m * 16) * DM + col0;
#pragma unroll
                for (int bj = 0; bj < 2; ++bj)
#pragma unroll
                    for (int n = 0; n < 2; ++n) { const size_t o = ro + bj * 128 + n * 16; const f32x4 r = *(const f32x4*)(res + o); *(f32x4*)(out + o) = acc[ai][bj][m][n] + r; } }
    }
};
template <class Epi> __device__ __forceinline__ void run_gemm(LAS unsigned char* lds, const bf16_t* A, const bf16_t* Bt, int M, int N, int K, const Epi& E) {
    Gemm g; g.A = A; g.Bt = Bt; g.M = M; g.N = N; g.K = K;
    StaticOrder S; S.init(M, N, (int)gridDim.x, (int)blockIdx.x);
    pg8::gemm_phase<Epi, StaticOrder, false>(lds, g, S, E, nullptr);
}

__device__ __forceinline__ void subln_gate_store(LAS unsigned char* lds, const float* __restrict__ g, float oscale, const bf16_t* __restrict__ gate, bf16_t* __restrict__ dst, int ld) {
    const int tid_ = mk_opaque_tid(), wid = tid_ >> 6, lane = tid_ & 63, cc = lane & 31;
    f32x4 g0 = *(const f32x4*)(g + cc * 8), g1 = *(const f32x4*)(g + cc * 8 + 4);
#pragma unroll
    for (int j = 0; j < 8; ++j) {
        const int row = 16 * wid + 2 * j + (lane >> 5);
        const f32x4 a = *(const LAS f32x4*)(lds + (row * 256 + cc * 8) * 4), b = *(const LAS f32x4*)(lds + (row * 256 + cc * 8 + 4) * 4);
        const u32x4 gt = *(const u32x4*)(gate + (size_t)row * ld + cc * 8);
        float ss = a[0] * a[0] + a[1] * a[1] + a[2] * a[2] + a[3] * a[3] + b[0] * b[0] + b[1] * b[1] + b[2] * b[2] + b[3] * b[3];
#pragma unroll
        for (int o = 16; o >= 1; o >>= 1) ss += __shfl_xor(ss, o);
        const float rs = rsqrtf(ss * (1.0f / 256.0f) + 1e-5f) * oscale;
        float gg[8] = {bflo(gt.x), bfhi(gt.x), bflo(gt.y), bfhi(gt.y), bflo(gt.z), bfhi(gt.z), bflo(gt.w), bfhi(gt.w)};
        float y[8] = {a[0] * g0[0], a[1] * g0[1], a[2] * g0[2], a[3] * g0[3], b[0] * g1[0], b[1] * g1[1], b[2] * g1[2], b[3] * g1[3]};
#pragma unroll
        for (int e = 0; e < 8; ++e) { const float sg = gg[e] * __builtin_amdgcn_rcpf(1.0f + __expf(-gg[e])); y[e] = y[e] * rs * sg; }
        u32x4 w; w.x = cvt_pk_bf16(y[0], y[1]); w.y = cvt_pk_bf16(y[2], y[3]); w.z = cvt_pk_bf16(y[4], y[5]); w.w = cvt_pk_bf16(y[6], y[7]);
        *(u32x4*)(dst + (size_t)row * ld + cc * 8) = w;
    }
}

constexpr float LOG2E = 1.4426950408889634f, ATHR = 8.0f;
__device__ __forceinline__ void partialSM(f32x16& p0, f32x16& p1, float& m_reg, float& mn, float& alpha) {
    float pmax = p0[0];
#pragma unroll
    for (int r = 1; r < 16; ++r) pmax = fmaxf(pmax, p0[r]);
#pragma unroll
    for (int r = 0; r < 16; ++r) pmax = fmaxf(pmax, p1[r]);
    { auto rr = __builtin_amdgcn_permlane32_swap(__float_as_uint(pmax), __float_as_uint(pmax), false, false); pmax = fmaxf(__uint_as_float(rr[0]), __uint_as_float(rr[1])); }
    if (__builtin_expect(__all(pmax - m_reg <= ATHR), 1)) { mn = m_reg; alpha = 1.f; }
    else { mn = fmaxf(m_reg, pmax); alpha = __builtin_amdgcn_exp2f((m_reg - mn) * LOG2E); m_reg = mn; }
    const float mnC = -mn * LOG2E;
#pragma unroll
    for (int r = 0; r < 16; ++r) p0[r] = __builtin_amdgcn_exp2f(fmaf(p0[r], LOG2E, mnC));
#pragma unroll
    for (int r = 0; r < 16; ++r) p1[r] = __builtin_amdgcn_exp2f(fmaf(p1[r], LOG2E, mnC));
}
__device__ __forceinline__ void finishSM(f32x16& p0, f32x16& p1, float alpha, float& l_reg, bf16x8& pa0, bf16x8& pa1, bf16x8& pa2, bf16x8& pa3) {
    float ps = 0;
#pragma unroll
    for (int r = 0; r < 16; ++r) ps += p0[r];
#pragma unroll
    for (int r = 0; r < 16; ++r) ps += p1[r];
    { auto rr = __builtin_amdgcn_permlane32_swap(__float_as_uint(ps), __float_as_uint(ps), false, false); ps = __uint_as_float(rr[0]) + __uint_as_float(rr[1]); }
    l_reg = l_reg * alpha + ps;
    PK4(p0, 0, pa0); PK4(p0, 8, pa1); PK4(p1, 0, pa2); PK4(p1, 8, pa3);
}
template <int D0> __device__ __forceinline__ void pv_one(f32x16& od, unsigned vb, bf16x8 pa0, bf16x8 pa1, bf16x8 pa2, bf16x8 pa3) {
    const s16x4 l0 = tr_read<D0 * 512 + 0 * 8192>(vb), h0 = tr_read<D0 * 512 + 0 * 8192 + 4096>(vb), l1 = tr_read<D0 * 512 + 1 * 8192>(vb), h1 = tr_read<D0 * 512 + 1 * 8192 + 4096>(vb);
    const s16x4 l2 = tr_read<D0 * 512 + 2 * 8192>(vb), h2 = tr_read<D0 * 512 + 2 * 8192 + 4096>(vb), l3 = tr_read<D0 * 512 + 3 * 8192>(vb), h3 = tr_read<D0 * 512 + 3 * 8192 + 4096>(vb);
    asm volatile("s_waitcnt lgkmcnt(0)" ::: "memory"); SBAR();
    od = __builtin_amdgcn_mfma_f32_32x32x16_bf16(pa0, PKLH(l0, h0), od, 0, 0, 0);
    od = __builtin_amdgcn_mfma_f32_32x32x16_bf16(pa1, PKLH(l1, h1), od, 0, 0, 0);
    od = __builtin_amdgcn_mfma_f32_32x32x16_bf16(pa2, PKLH(l2, h2), od, 0, 0, 0);
    od = __builtin_amdgcn_mfma_f32_32x32x16_bf16(pa3, PKLH(l3, h3), od, 0, 0, 0);
}

__device__ __forceinline__ void attn_phase(const Params& P, LAS unsigned char* lds) {
    constexpr int NT = SEQ / 64;
    for (int it = blockIdx.x; it < GSEQ * 8 * 32; it += gridDim.x) {
        const int tid = mk_opaque_tid(), wid = __builtin_amdgcn_readfirstlane(tid >> 6), lane = tid & 63, r32 = lane & 31, hi = lane >> 5;
        const int map = wid >> 2, wq = wid & 3;
        bf16_t* qbuf = (bf16_t*)(P.ws + OFF_BIG); const bf16_t* kbuf = qbuf + (size_t)MR * 2048; const bf16_t* vbuf = kbuf + (size_t)MR * 2048; const bf16_t* gbuf = vbuf + (size_t)MR * 2048;
        const unsigned lds0 = (unsigned)(size_t)lds;
        LAS float* li_l = (LAS float*)(lds + 131072 + wid * 256); LAS float* al_l = li_l + 32;
        const unsigned kL = (unsigned)((4 * wid + (lane >> 4)) * 2048 + (((lane & 15) ^ (4 * (wid & 1) + (lane >> 4))) * 8)) * 2u;
        const unsigned vL = (unsigned)((8 * ((lane >> 4) & 1) + 4 * (wid >> 2) + ((lane >> 2) & 3)) * 2048 + (2 * (wid & 3) + (lane >> 5)) * 32 + (lane & 3) * 8) * 2u;
        const int head = it & 7, qblk = (it >> 3) & 31, seq = it >> 8;
        const size_t tok0 = (size_t)seq * SEQ;
        const char* kb = (const char*)(kbuf + tok0 * 2048 + (2 * head) * 128);
        const char* vb = (const char*)(vbuf + tok0 * 2048 + head * 256);
#define AT_ISSUE(st, k0) do { LAS unsigned char* s_ = lds + (st) * 65536 + wid * 1024; const unsigned ko_ = kL + (unsigned)(k0) * 4096u, vo_ = vL + (unsigned)(k0) * 4096u; \
        __builtin_amdgcn_global_load_lds((const unsigned*)(kb + ko_), (LAS unsigned*)(s_), 16, 0, 0); \
        __builtin_amdgcn_global_load_lds((const unsigned*)(kb + (ko_ + 32u * 4096u)), (LAS unsigned*)(s_ + 8192), 16, 0, 0); \
        __builtin_amdgcn_global_load_lds((const unsigned*)(kb + (ko_ + 256u)), (LAS unsigned*)(s_ + 16384), 16, 0, 0); \
        __builtin_amdgcn_global_load_lds((const unsigned*)(kb + (ko_ + 256u + 32u * 4096u)), (LAS unsigned*)(s_ + 16384 + 8192), 16, 0, 0); \
        __builtin_amdgcn_global_load_lds((const unsigned*)(vb + vo_), (LAS unsigned*)(s_ + 32768), 16, 0, 0); \
        __builtin_amdgcn_global_load_lds((const unsigned*)(vb + (vo_ + 16u * 4096u)), (LAS unsigned*)(s_ + 32768 + 8192), 16, 0, 0); \
        __builtin_amdgcn_global_load_lds((const unsigned*)(vb + (vo_ + 32u * 4096u)), (LAS unsigned*)(s_ + 32768 + 16384), 16, 0, 0); \
        __builtin_amdgcn_global_load_lds((const unsigned*)(vb + (vo_ + 48u * 4096u)), (LAS unsigned*)(s_ + 32768 + 24576), 16, 0, 0); } while (0)
        const size_t qrow0 = tok0 + qblk * 128;
        bf16x8 qr[8];
        { const bf16_t* qp = qbuf + (qrow0 + wq * 32 + r32) * 2048 + (2 * head + map) * 128 + hi * 8;
#pragma unroll
          for (int d0 = 0; d0 < 8; ++d0) qr[d0] = *(const bf16x8*)(qp + d0 * 16); }
        AT_ISSUE(0, 0);
        asm volatile("s_waitcnt vmcnt(0)" ::: "memory"); MK_BAR();
        AT_ISSUE(1, 64);
        float m_reg = -1e30f, l_reg = 0.f; f32x16 o[8];
#pragma unroll
        for (int d = 0; d < 8; ++d) o[d] = f32x16{};
        for (int j = 0; j < NT; ++j) {
            const unsigned st = (unsigned)(j & 1) * 65536u;
            f32x16 p0 = f32x16{}, p1 = f32x16{};
            { const LAS unsigned char* Ks = lds + st + map * 16384;
#pragma unroll
              for (int d0 = 0; d0 < 8; ++d0) { const int cb = (d0 * 16 + hi * 8) * 2;
                  const bf16x8 b0 = *(const LAS bf16x8*)(Ks + KSWZ(r32, cb)); const bf16x8 b1 = *(const LAS bf16x8*)(Ks + 8192 + KSWZ(r32, cb));
                  p0 = __builtin_amdgcn_mfma_f32_32x32x16_bf16(b0, qr[d0], p0, 0, 0, 0);
                  p1 = __builtin_amdgcn_mfma_f32_32x32x16_bf16(b1, qr[d0], p1, 0, 0, 0); if (d0 & 1) SBAR(); } }
            float mn, al; partialSM(p0, p1, m_reg, mn, al);
            if (__any(al < 1.f)) { if (hi == 0) al_l[r32] = al; asm volatile("s_waitcnt lgkmcnt(0)" ::: "memory");
#pragma unroll
                for (int r = 0; r < 16; ++r) { const float a = al_l[crow(r, hi)];
#pragma unroll
                    for (int d = 0; d < 8; ++d) o[d][r] *= a; } }
            bf16x8 pa0, pa1, pa2, pa3; finishSM(p0, p1, al, l_reg, pa0, pa1, pa2, pa3);
            const unsigned vb0 = lds0 + st + 32768u + (unsigned)v_rd_base(lane);
            pv_one<0>(o[0], vb0, pa0, pa1, pa2, pa3); pv_one<1>(o[1], vb0, pa0, pa1, pa2, pa3); pv_one<2>(o[2], vb0, pa0, pa1, pa2, pa3); pv_one<3>(o[3], vb0, pa0, pa1, pa2, pa3);
            pv_one<4>(o[4], vb0, pa0, pa1, pa2, pa3); pv_one<5>(o[5], vb0, pa0, pa1, pa2, pa3); pv_one<6>(o[6], vb0, pa0, pa1, pa2, pa3); pv_one<7>(o[7], vb0, pa0, pa1, pa2, pa3);
            asm volatile("s_waitcnt vmcnt(0)" ::: "memory"); MK_BAR();
            if (j + 2 < NT) { if (j & 1) AT_ISSUE(1, (j + 2) * 64); else AT_ISSUE(0, (j + 2) * 64); }
        }
#undef AT_ISSUE
        float lam;
        { float a = P.lq1[lane] * P.lk1[lane] + P.lq1[lane + 64] * P.lk1[lane + 64], b = P.lq2[lane] * P.lk2[lane] + P.lq2[lane + 64] * P.lk2[lane + 64];
    #pragma unroll
          for (int o = 32; o >= 1; o >>= 1) { a += __shfl_xor(a, o); b += __shfl_xor(b, o); }
          lam = __expf(a) - __expf(b) + 0.2f; }
        if (hi == 0) li_l[r32] = l_reg; asm volatile("s_waitcnt lgkmcnt(0)" ::: "memory");
        LAS unsigned char* reg = lds + wq * 32768;
        if (map == 1) {
#pragma unroll
            for (int r = 0; r < 16; ++r) { const float s = lam * __builtin_amdgcn_rcpf(li_l[crow(r, hi)]);
#pragma unroll
                for (int d = 0; d < 8; ++d) *(LAS float*)(reg + ((d * 16 + r) * 64 + lane) * 4) = o[d][r] * s; }
        }
        MK_BAR();
        if (map == 0) {
#pragma unroll
            for (int r = 0; r < 16; ++r) { const float s = __builtin_amdgcn_rcpf(li_l[crow(r, hi)]);
#pragma unroll
                for (int d = 0; d < 8; ++d) o[d][r] = o[d][r] * s - *(const LAS float*)(reg + ((d * 16 + r) * 64 + lane) * 4); }
            asm volatile("s_waitcnt lgkmcnt(0)" ::: "memory");
#pragma unroll
            for (int r = 0; r < 16; ++r)
#pragma unroll
                for (int d = 0; d < 8; ++d) *(LAS float*)(reg + (crow(r, hi) * 256 + d * 32 + r32) * 4) = o[d][r];
        }
        MK_BAR();
        subln_gate_store(lds, P.da_subln_g, 0.8f, gbuf + qrow0 * 2048 + head * 256, qbuf + qrow0 * 2048 + head * 256, 2048);
        MK_BAR();
    }
}

__device__ __forceinline__ void ret_chain_phase(const Params& P, LAS unsigned char* lds) {
    const int tid = mk_opaque_tid(), wid = __builtin_amdgcn_readfirstlane(tid >> 6), lane = tid & 63, r32 = lane & 31, hi = lane >> 5;
    const int sr = tid >> 4, sc = (tid & 15) * 8, m0 = wid & 3, nb0 = 2 * (wid >> 2);
    const bf16_t* rk = (const bf16_t*)(P.ws + OFF_RK); const bf16_t* rv = (const bf16_t*)(P.ws + OFF_RV);
    const unsigned lds0 = (unsigned)(size_t)lds;
    const unsigned abase = lds0 + (unsigned)v_rd_base(lane) + (unsigned)m0 * 512u, bbase = lds0 + 32768u + (unsigned)v_rd_base(lane) + (unsigned)nb0 * 512u;
    for (int cid = blockIdx.x; cid < GSEQ * 8 * 4; cid += gridDim.x) {
        const int dvh = cid & 1, dir = (cid >> 1) & 1, head = (cid >> 2) & 7, seq = cid >> 5;
        const float lg = -__expf((dir ? P.ret_decay_bwd : P.ret_decay_fwd)[head]) * LOG2E;
        const float cdec = __builtin_amdgcn_exp2f(128.f * lg);
        const bf16_t* kb = rk + (size_t)seq * SEQ * 1024 + head * 128 + sc;
        const bf16_t* vb = rv + (size_t)seq * SEQ * 2048 + head * 256 + dvh * 128 + sc;
        bf16_t* Sbase = (bf16_t*)(P.ws + (dir ? OFF_SB : OFF_SF)) + (size_t)((seq * 8 + head) * 32) * 32768;
        f32x16 acc[2]; acc[0] = f32x16{}; acc[1] = f32x16{};
        bf16x8 kreg[4], vreg[4];
        int c = dir ? 31 : 0;
#pragma unroll
        for (int i = 0; i < 4; ++i) { kreg[i] = *(const bf16x8*)(kb + (size_t)(c * 128 + sr + 32 * i) * 1024); vreg[i] = *(const bf16x8*)(vb + (size_t)(c * 128 + sr + 32 * i) * 2048); }
        for (int s = 0; s < 32; ++s) {
            { bf16_t* Sc = Sbase + (size_t)c * 32768;
#pragma unroll
              for (int nb = 0; nb < 2; ++nb)
#pragma unroll
                  for (int q4 = 0; q4 < 4; ++q4) { const int dv = dvh * 128 + 32 * (nb0 + nb) + r32, dk = 32 * m0 + 8 * q4 + 4 * hi;
                      uint2 w; w.x = cvt_pk_bf16(acc[nb][4 * q4 + 0], acc[nb][4 * q4 + 1]); w.y = cvt_pk_bf16(acc[nb][4 * q4 + 2], acc[nb][4 * q4 + 3]);
                      *(uint2*)(Sc + dv * 128 + dk) = w; } }
            if (s == 31) break;
#pragma unroll
            for (int i = 0; i < 4; ++i) { const int j = sr + 32 * i; const float f = __builtin_amdgcn_exp2f(lg * (float)(dir ? j : 127 - j));
                *(LAS bf16x8*)(lds + v_st<4>(j, sc)) = scale8(kreg[i], f); *(LAS bf16x8*)(lds + 32768 + v_st<4>(j, sc)) = vreg[i]; }
            const int cn = dir ? c - 1 : c + 1;
            if (s + 1 < 31) {
#pragma unroll
                for (int i = 0; i < 4; ++i) { kreg[i] = *(const bf16x8*)(kb + (size_t)(cn * 128 + sr + 32 * i) * 1024); vreg[i] = *(const bf16x8*)(vb + (size_t)(cn * 128 + sr + 32 * i) * 2048); } }
            __syncthreads();
#pragma unroll
            for (int r = 0; r < 16; ++r) { acc[0][r] *= cdec; acc[1][r] *= cdec; }
#define CH_STEP(KS) do { const s16x4 al_ = tr_read<(KS) * 4096>(abase), ah_ = tr_read<(KS) * 4096 + 2048>(abase); \
                const s16x4 b0l_ = tr_read<(KS) * 4096>(bbase), b0h_ = tr_read<(KS) * 4096 + 2048>(bbase), b1l_ = tr_read<512 + (KS) * 4096>(bbase), b1h_ = tr_read<512 + (KS) * 4096 + 2048>(bbase); \
                asm volatile("s_waitcnt lgkmcnt(0)" ::: "memory"); SBAR(); \
                acc[0] = __builtin_amdgcn_mfma_f32_32x32x16_bf16(PKLH(al_, ah_), PKLH(b0l_, b0h_), acc[0], 0, 0, 0); \
                acc[1] = __builtin_amdgcn_mfma_f32_32x32x16_bf16(PKLH(al_, ah_), PKLH(b1l_, b1h_), acc[1], 0, 0, 0); } while (0)
            CH_STEP(0); CH_STEP(1); CH_STEP(2); CH_STEP(3); CH_STEP(4); CH_STEP(5); CH_STEP(6); CH_STEP(7);
#undef CH_STEP
            __syncthreads();
            c = cn;
        }
    }
}

template <int D0> __device__ __forceinline__ void ro_pv(f32x16& od, unsigned vb, const bf16x8 (&pa)[8]) {
#define RO_ST(KS) do { const s16x4 l_ = tr_read<D0 * 512 + (KS) * 8192>(vb), h_ = tr_read<D0 * 512 + (KS) * 8192 + 4096>(vb); asm volatile("s_waitcnt lgkmcnt(0)" ::: "memory"); SBAR(); \
        od = __builtin_amdgcn_mfma_f32_32x32x16_bf16(pa[KS], PKLH(l_, h_), od, 0, 0, 0); } while (0)
    RO_ST(0); RO_ST(1); RO_ST(2); RO_ST(3); RO_ST(4); RO_ST(5); RO_ST(6); RO_ST(7);
#undef RO_ST
}
__device__ __forceinline__ void ret_out_phase(const Params& P, LAS unsigned char* lds) {
    for (int it = blockIdx.x; it < GSEQ * 8 * 32; it += gridDim.x) {
        const int tid = mk_opaque_tid(), wid = __builtin_amdgcn_readfirstlane(tid >> 6), lane = tid & 63, r32 = lane & 31, hi = lane >> 5;
        const int wq = wid & 3, wh = wid >> 2;
        const bf16_t* rq = (const bf16_t*)(P.ws + OFF_RQ); const bf16_t* rk = (const bf16_t*)(P.ws + OFF_RK); bf16_t* rv = (bf16_t*)(P.ws + OFF_RV); const bf16_t* rg = (const bf16_t*)(P.ws + OFF_RG);
        const bf16_t* SF = (const bf16_t*)(P.ws + OFF_SF); const bf16_t* SB = (const bf16_t*)(P.ws + OFF_SB);
        const unsigned lds0 = (unsigned)(size_t)lds;
        LAS unsigned char* bufA = lds; LAS unsigned char* bufB = lds + 65536;
        const int rowL = 4 * wid + (lane >> 4), chL = ((lane & 15) ^ (4 * (wid & 1) + (lane >> 4))) * 8;
        const unsigned kL = (unsigned)(rowL * 1024 + chL) * 2u, sL = (unsigned)(rowL * 128 + chL) * 2u;
        const unsigned vL = (unsigned)((8 * ((lane >> 4) & 1) + 4 * (wid >> 2) + ((lane >> 2) & 3)) * 2048 + (2 * (wid & 3) + (lane >> 5)) * 32 + (lane & 3) * 8) * 2u;
        const int chunk = it & 31, head = (it >> 5) & 7, seq = it >> 8;
        const size_t tokc = (size_t)seq * SEQ + chunk * 128;
        const float lgf = -__expf(P.ret_decay_fwd[head]) * LOG2E, lgb = -__expf(P.ret_decay_bwd[head]) * LOG2E;
        const char* SfT = (const char*)(SF + (size_t)((seq * 8 + head) * 32 + chunk) * 32768); const char* SbT = (const char*)(SB + (size_t)((seq * 8 + head) * 32 + chunk) * 32768);
        const char* kbp = (const char*)(rk + tokc * 1024 + head * 128); const char* vbp = (const char*)(rv + tokc * 2048 + head * 256);
#pragma unroll
        for (int i = 0; i < 4; ++i) __builtin_amdgcn_global_load_lds((const unsigned*)(kbp + (kL + (unsigned)i * (32u * 2048u))), (LAS unsigned*)(bufB + i * 8192 + wid * 1024), 16, 0, 0);
#pragma unroll
        for (int i = 0; i < 8; ++i) __builtin_amdgcn_global_load_lds((const unsigned*)(vbp + (vL + (unsigned)i * (16u * 4096u))), (LAS unsigned*)(bufA + i * 8192 + wid * 1024), 16, 0, 0);
        bf16x8 qr[8];
        { const bf16_t* qp = rq + (tokc + wq * 32 + r32) * 1024 + head * 128 + hi * 8;
#pragma unroll
          for (int d0 = 0; d0 < 8; ++d0) qr[d0] = *(const bf16x8*)(qp + d0 * 16); }
        asm volatile("s_waitcnt vmcnt(0)" ::: "memory"); MK_BAR();
        const int n = 32 * wq + r32;
        bf16x8 pa[8];
#pragma unroll
        for (int kb = 0; kb < 4; ++kb) { f32x16 p = f32x16{};
#pragma unroll
            for (int d0 = 0; d0 < 8; ++d0) { const bf16x8 a = *(const LAS bf16x8*)(bufB + kb * 8192 + KSWZ(r32, (d0 * 16 + hi * 8) * 2)); p = __builtin_amdgcn_mfma_f32_32x32x16_bf16(a, qr[d0], p, 0, 0, 0); }
#pragma unroll
            for (int r = 0; r < 16; ++r) { const int d = n - (32 * kb + crow(r, hi)); const float e = d >= 0 ? (float)d * lgf : (float)(-d) * lgb; p[r] *= __builtin_amdgcn_exp2f(e); }
            PK4(p, 0, pa[2 * kb]); PK4(p, 8, pa[2 * kb + 1]); SBAR(); }
        f32x16 o[4];
#pragma unroll
        for (int d = 0; d < 4; ++d) o[d] = f32x16{};
        { const unsigned vb0 = lds0 + (unsigned)v_rd_base(lane) + (unsigned)(4 * wh) * 512u;
          ro_pv<0>(o[0], vb0, pa); ro_pv<1>(o[1], vb0, pa); ro_pv<2>(o[2], vb0, pa); ro_pv<3>(o[3], vb0, pa); }
        MK_BAR();
#pragma unroll
        for (int i = 0; i < 8; ++i) __builtin_amdgcn_global_load_lds((const unsigned*)(SfT + (sL + (unsigned)i * 8192u)), (LAS unsigned*)(bufB + i * 8192 + wid * 1024), 16, 0, 0);
#pragma unroll
        for (int i = 0; i < 8; ++i) __builtin_amdgcn_global_load_lds((const unsigned*)(SbT + (sL + (unsigned)i * 8192u)), (LAS unsigned*)(bufA + i * 8192 + wid * 1024), 16, 0, 0);
        asm volatile("s_waitcnt vmcnt(0)" ::: "memory"); MK_BAR();
        { const float qs = __builtin_amdgcn_exp2f(lgf * (float)(n + 1));
#pragma unroll
          for (int ks = 0; ks < 8; ++ks) { const bf16x8 qf = scale8(qr[ks], qs);
#pragma unroll
              for (int d0 = 0; d0 < 4; ++d0) { const bf16x8 b = *(const LAS bf16x8*)(bufB + (128 * wh + 32 * d0) * 256 + KSWZ(r32, (16 * ks + 8 * hi) * 2)); o[d0] = __builtin_amdgcn_mfma_f32_32x32x16_bf16(qf, b, o[d0], 0, 0, 0); } SBAR(); } }
        { const float qs = __builtin_amdgcn_exp2f(lgb * (float)(128 - n));
#pragma unroll
          for (int ks = 0; ks < 8; ++ks) { const bf16x8 qf = scale8(qr[ks], qs);
#pragma unroll
              for (int d0 = 0; d0 < 4; ++d0) { const bf16x8 b = *(const LAS bf16x8*)(bufA + (128 * wh + 32 * d0) * 256 + KSWZ(r32, (16 * ks + 8 * hi) * 2)); o[d0] = __builtin_amdgcn_mfma_f32_32x32x16_bf16(qf, b, o[d0], 0, 0, 0); } SBAR(); } }
        MK_BAR();
#pragma unroll
        for (int r = 0; r < 16; ++r)
#pragma unroll
            for (int d = 0; d < 4; ++d) *(LAS float*)(lds + ((32 * wq + crow(r, hi)) * 256 + 128 * wh + 32 * d + r32) * 4) = o[d][r];
        MK_BAR();
        subln_gate_store(lds, P.ret_subln_g, 1.0f, rg + tokc * 2048 + head * 256, rv + tokc * 2048 + head * 256, 2048);
        MK_BAR();
    }
}

__global__ void __launch_bounds__(512) mega(Params P) {
    extern __shared__ __attribute__((aligned(16))) unsigned char shm[];
    LAS unsigned char* lds = (LAS unsigned char*)shm;
    cg::grid_group grid = cg::this_grid();
    bf16_t* H = (bf16_t*)(P.ws + OFF_H); bf16_t* big = (bf16_t*)(P.ws + OFF_BIG);
    const bf16_t* WinDA = (const bf16_t*)(P.ws + OFF_WIN_DA); const bf16_t* WoutDA = (const bf16_t*)(P.ws + OFF_WOUT_DA);
    const bf16_t* WinRET = (const bf16_t*)(P.ws + OFF_WIN_RET); const bf16_t* WoutRET = (const bf16_t*)(P.ws + OFF_WOUT_RET);
    const float* tab = (const float*)(P.ws + OFF_TAB);
    prep_phase(P, lds);
    norm_to_bf16(P.x_prompt, P.norm_g, H, MR);
    grid.sync();
    for (int r = 0; r < NROUND; ++r) {
        const float* xin = r < 2 ? P.x_prompt + (size_t)r * MR * DM : P.x_sample;
        float* xout = P.out + (size_t)r * MR * DM;
        { EpiDA E; E.big = big; E.tcos = tab; E.tsin = tab + 262144; run_gemm(lds, H, WinDA, MR, 8192, 1024, E); }
        grid.sync();
        attn_phase(P, lds);
        grid.sync();
        { EpiRes E; E.out = xout; E.res = xin; run_gemm(lds, big, WoutDA, MR, 1024, 2048, E); }
        if (r + 1 < NROUND) { const float* xn = (r + 1) < 2 ? P.x_prompt + (size_t)(r + 1) * MR * DM : P.x_sample; norm_to_bf16(xn, P.norm_g, H, MR); }
        else norm_to_bf16(P.out, P.norm_g + DM, H, MR);
        grid.sync();
    }
    for (int r = 0; r < NROUND; ++r) {
        float* xio = P.out + (size_t)r * MR * DM;
        { EpiRET E; E.rq = (bf16_t*)(P.ws + OFF_RQ); E.rk = (bf16_t*)(P.ws + OFF_RK); E.rv = (bf16_t*)(P.ws + OFF_RV); E.rg = (bf16_t*)(P.ws + OFF_RG); E.tcos = tab + 2 * 262144; E.tsin = tab + 3 * 262144;
          run_gemm(lds, H, WinRET, MR, 6144, 1024, E); }
        if (r > 0) norm_inplace_f32(P.out + (size_t)(r - 1) * MR * DM, P.final_norm_g, MR);
        grid.sync();
        ret_chain_phase(P, lds);
        grid.sync();
        ret_out_phase(P, lds);
        grid.sync();
        { EpiRes E; E.out = xio; E.res = xio; run_gemm(lds, (const bf16_t*)(P.ws + OFF_RV), WoutRET, MR, 1024, 2048, E); }
        if (r + 1 < NROUND) norm_to_bf16(P.out + (size_t)(r + 1) * MR * DM, P.norm_g + DM, H, MR);
        grid.sync();
    }
    norm_inplace_f32(P.out + (size_t)(NROUND - 1) * MR * DM, P.final_norm_g, MR);
}
}

extern "C" void kernel_launch(void* const* d_in, const int* in_sizes, int n_in, void* d_out, int out_size, void* d_ws, size_t ws_size, hipStream_t stream) {
    static int grid_blocks = 0;
    if (!grid_blocks) {
        if (hipFuncSetAttribute((const void*)mk::mega, hipFuncAttributeMaxDynamicSharedMemorySize, (int)mk::LDS_BYTES) != hipSuccess) fprintf(stderr, "kernel_launch: LDS attribute failed\n");
        int dev = 0, cus = 0, per = 0; hipGetDevice(&dev); hipDeviceGetAttribute(&cus, hipDeviceAttributeMultiprocessorCount, dev);
        hipOccupancyMaxActiveBlocksPerMultiprocessor(&per, mk::mega, 512, mk::LDS_BYTES);
        if (per < 1) fprintf(stderr, "kernel_launch: occupancy query says %d blocks/CU\n", per);
        grid_blocks = cus > 0 ? cus : 256;
    }
    mk::Params p{};
    p.x_prompt = (const float*)d_in[0]; p.x_sample = (const float*)d_in[1]; p.norm_g = (const float*)d_in[2]; p.da_w_in = (const float*)d_in[3];
    p.lq1 = (const float*)d_in[4]; p.lk1 = (const float*)d_in[5]; p.lq2 = (const float*)d_in[6]; p.lk2 = (const float*)d_in[7];
    p.da_subln_g = (const float*)d_in[8]; p.da_w_out = (const float*)d_in[9]; p.ret_w_in = (const float*)d_in[10]; p.ret_decay_fwd = (const float*)d_in[11];
    p.ret_decay_bwd = (const float*)d_in[12]; p.ret_subln_g = (const float*)d_in[13]; p.ret_w_out = (const float*)d_in[14]; p.final_norm_g = (const float*)d_in[15];
    p.out = (float*)d_out; p.ws = (unsigned char*)d_ws;
    void* args[] = {&p};
    hipError_t e = hipLaunchCooperativeKernel((void*)mk::mega, dim3(grid_blocks), dim3(512), args, (unsigned)mk::LDS_BYTES, stream);
    if (e != hipSuccess) fprintf(stderr, "kernel_launch: cooperative launch failed: %s (grid %d)\n", hipGetErrorString(e), grid_blocks);
}
```

```cpp
#include <hip/hip_runtime.h>
#include <hip/hip_cooperative_groups.h>
#include <cstdio>
namespace cg = cooperative_groups;
__device__ __forceinline__ int mk_opaque_tid() { int t = threadIdx.x; asm volatile("" : "+v"(t)); return t; }
namespace pg8 {
#define PG8_LAS __attribute__((address_space(3)))
typedef unsigned short bf16_t;
typedef short bf16x8 __attribute__((ext_vector_type(8)));
typedef float f32x4 __attribute__((ext_vector_type(4)));
typedef unsigned u32x4 __attribute__((ext_vector_type(4)));
constexpr int BM = 256, BK = 64, HALF = 128, HTB = HALF * BK * 2  , STAGE_BYTES = 8 * HTB, NXCD = 8, WGM = 8;

__host__ __device__ __forceinline__ int lds_byte(int r, int c) { const int st = (r >> 4) * 2 + (c >> 5), rr = r & 15, cc = c & 31, ob = rr * 64 + cc * 2; return st * 1024 + (ob ^ (((ob >> 9) & 1) << 5)); }
__host__ __device__ __forceinline__ void stage_rc(int b, int& R, int& C) { const int st = b / 1024, sb = b % 1024, swz = sb ^ (((sb >> 9) & 1) << 5); R = (st >> 1) * 16 + swz / 64; C = (st & 1) * 32 + (swz % 64) / 2; }
__host__ __device__ __forceinline__ int perm32(int rho) { const int n = rho >> 4, i = rho & 15; return 8 * (i >> 2) + 4 * n + (i & 3); }

struct Unit { int pm, pn; };
struct Gemm { const bf16_t* A; const bf16_t* Bt; int M, N, K; };

struct StaticOrder {
    int nM, nN, nwg, G, c;
    __host__ __device__ void init(int M, int N, int G_, int c_) { nM = M / BM; nN = N / BM; nwg = nM * nN; G = G_; c = c_; }
    __host__ __device__ bool next(int i, Unit& u) const {
        const long L = (long)i * G + c; if (L >= nwg) return false;
        int wgid = (int)L; { const int q = nwg / NXCD, r = nwg % NXCD, xcd = wgid % NXCD, off = wgid / NXCD; wgid = (xcd < r ? xcd * (q + 1) : r * (q + 1) + (xcd - r) * q) + off; }
        const int nig = WGM * nN, gid = wgid / nig, fm = gid * WGM, gsz = (nM - fm) < WGM ? (nM - fm) : WGM;
        u.pm = fm + ((wgid % nig) % gsz); u.pn = (wgid % nig) / gsz; return true;
    }
    __device__ __forceinline__ void a_ready(const Unit&) const {}
    __device__ __forceinline__ void done(const Unit&) const {}
};
__device__ __forceinline__ unsigned cvt_pk_bf16(float lo, float hi) { unsigned r; asm volatile("v_cvt_pk_bf16_f32 %0, %1, %2" : "=v"(r) : "v"(lo), "v"(hi)); return r; }
template <class Epi, class Sched, bool STAMP = false>
__device__ __forceinline__ void gemm_phase(PG8_LAS unsigned char* lds, const Gemm g, const Sched& S, const Epi& E, unsigned long long* stamps) {
    const int tid = mk_opaque_tid(), wid = __builtin_amdgcn_readfirstlane(tid >> 6), lane = tid & 63, wr = wid >> 2, wc = wid & 3, fr = lane & 15, fq = lane >> 4;
    const int K = g.K, nt = K / BK;
    int ts_lo = 0, ts_hi = 0, nts = 0; const unsigned long long rt_entry = STAMP ? (unsigned long long)wall_clock64() : 0ull;
#define PG8_STAMP() do { if (STAMP && wid == 0 && nts < 64) { const unsigned long long _c = (unsigned long long)clock64(); \
        ts_lo = (lane == nts) ? (int)(unsigned)_c : ts_lo; ts_hi = (lane == nts) ? (int)(unsigned)(_c >> 32) : ts_hi; ++nts; } } while (0)
    PG8_STAMP();
    unsigned voffA[2], voffB[2];
#pragma unroll
    for (int i = 0; i < 2; ++i) { int R, C; stage_rc(tid * 16 + i * 8192, R, C); const int Rb = Epi::PERM ? ((R & ~31) + perm32(R & 31)) : R;
        voffA[i] = (unsigned)(R * K + C) * 2u; voffB[i] = (unsigned)(Rb * K + C) * 2u; }
    const size_t kstep = (size_t)(BK * 2);
    const size_t hstep = (size_t)HALF * K * 2;
    const size_t tstep = 2 * hstep;
    const unsigned ldsw = (unsigned)wid * 1024u;
    const int aoff = lds_byte(wr * 64 + fr, fq * 8), boff = lds_byte(wc * 32 + fr, fq * 8);
#define PG8_SA(b, h) (((b) * 2 + (h)) * HTB)
#define PG8_SB(b, h) ((4 + (b) * 2 + (h)) * HTB)
#define PG8_STAGE(bufoff, gbase, voff) do { _Pragma("unroll") for (int _i = 0; _i < 2; ++_i) \
        __builtin_amdgcn_global_load_lds((const unsigned*)((const char*)(gbase) + (voff)[_i]), (PG8_LAS unsigned*)(lds + (bufoff) + ldsw + _i * 8192), 16, 0, 0); } while (0)
#define PG8_LDA(dst, b, h) do { _Pragma("unroll") for (int m = 0; m < 4; ++m) _Pragma("unroll") for (int k = 0; k < 2; ++k) dst[m][k] = *(const PG8_LAS bf16x8*)(lds + PG8_SA(b, h) + aoff + m * 2048 + k * 1024); } while (0)
#define PG8_LDB(dst, b, h) do { _Pragma("unroll") for (int n = 0; n < 2; ++n) _Pragma("unroll") for (int k = 0; k < 2; ++k) dst[n][k] = *(const PG8_LAS bf16x8*)(lds + PG8_SB(b, h) + boff + n * 2048 + k * 1024); } while (0)
#define PG8_MMA(ai, bj, At, Bt) do { __builtin_amdgcn_s_setprio(1); _Pragma("unroll") for (int m = 0; m < 4; ++m) _Pragma("unroll") for (int n = 0; n < 2; ++n) _Pragma("unroll") for (int k = 0; k < 2; ++k) \
        acc[ai][bj][m][n] = __builtin_amdgcn_mfma_f32_16x16x32_bf16(Bt[n][k], At[m][k], acc[ai][bj][m][n], 0, 0, 0); __builtin_amdgcn_s_setprio(0); } while (0)
#define PG8_WAIT_V(n) asm volatile("s_waitcnt vmcnt(" #n ")" ::: "memory")
#define PG8_WAIT_L(n) asm volatile("s_waitcnt lgkmcnt(" #n ")" ::: "memory")
#define PG8_BAR __builtin_amdgcn_s_barrier()
#define PG8_SCHED __builtin_amdgcn_sched_barrier(0)
    Unit cur, nxt; int ui = 0;
    if (!S.next(0, cur)) return;
    f32x4 acc[2][2][4][2];
#pragma unroll
    for (int a = 0; a < 2; ++a)
#pragma unroll
        for (int b = 0; b < 2; ++b)
#pragma unroll
            for (int m = 0; m < 4; ++m)
#pragma unroll
                for (int n = 0; n < 2; ++n) acc[a][b][m][n] = (f32x4){0.f, 0.f, 0.f, 0.f};
    bf16x8 At[4][2], B0[2][2], B1[2][2];
    const char* cA = (const char*)g.A + (size_t)cur.pm * tstep; const char* cB = (const char*)g.Bt + (size_t)cur.pn * tstep;
    S.a_ready(cur);
    PG8_STAGE(PG8_SB(0, 0), cB, voffB); PG8_STAGE(PG8_SA(0, 0), cA, voffA); PG8_STAGE(PG8_SB(0, 1), cB + hstep, voffB); PG8_STAGE(PG8_SA(0, 1), cA + hstep, voffA);
    if (wr == 1) PG8_BAR;
    PG8_WAIT_V(4); PG8_BAR;
    PG8_STAGE(PG8_SB(1, 0), cB + kstep, voffB); PG8_STAGE(PG8_SA(1, 0), cA + kstep, voffA); PG8_STAGE(PG8_SB(1, 1), cB + hstep + kstep, voffB);
    PG8_WAIT_V(6); PG8_BAR;
    PG8_STAMP();
    for (;;) {
        const bool has_next = S.next(ui + 1, nxt);
        const char* nA = has_next ? (const char*)g.A + (size_t)nxt.pm * tstep : cA; const char* nB = has_next ? (const char*)g.Bt + (size_t)nxt.pn * tstep : cB;
        for (int t = 0; t < nt; t += 2) {
            const bool last = (t == nt - 2);
            const char* a1 = cA + (size_t)(t + 1) * kstep;
            const char* a2 = last ? nA : cA + (size_t)(t + 2) * kstep; const char* b2 = last ? nB : cB + (size_t)(t + 2) * kstep;
            const char* a3 = a2 + kstep; const char* b3 = b2 + kstep;
            if (last && has_next) S.a_ready(nxt);
            PG8_LDB(B0, 0, 0); PG8_SCHED; PG8_LDA(At, 0, 0); PG8_STAGE(PG8_SA(1, 1), a1 + hstep, voffA);
            PG8_WAIT_L(8); PG8_BAR; PG8_WAIT_L(0); PG8_MMA(0, 0, At, B0); PG8_BAR; PG8_SCHED;
            PG8_LDB(B1, 0, 1); PG8_STAGE(PG8_SB(0, 0), b2, voffB);
            PG8_BAR; PG8_WAIT_L(0); PG8_MMA(0, 1, At, B1); PG8_BAR;
            PG8_LDA(At, 0, 1); PG8_STAGE(PG8_SA(0, 0), a2, voffA);
            PG8_BAR; PG8_WAIT_L(0); PG8_MMA(1, 0, At, B0); PG8_BAR; PG8_SCHED;
            PG8_STAGE(PG8_SB(0, 1), b2 + hstep, voffB);
            PG8_WAIT_V(6); PG8_BAR; PG8_MMA(1, 1, At, B1); PG8_BAR;
            PG8_LDB(B0, 1, 0); PG8_SCHED; PG8_LDA(At, 1, 0); PG8_STAGE(PG8_SA(0, 1), a2 + hstep, voffA);
            PG8_WAIT_L(8); PG8_BAR; PG8_WAIT_L(0); PG8_MMA(0, 0, At, B0); PG8_BAR; PG8_SCHED;
            PG8_LDB(B1, 1, 1); PG8_STAGE(PG8_SB(1, 0), b3, voffB);
            PG8_BAR; PG8_WAIT_L(0); PG8_MMA(0, 1, At, B1); PG8_BAR;
            PG8_LDA(At, 1, 1); PG8_STAGE(PG8_SA(1, 0), a3, voffA);
            PG8_BAR; PG8_WAIT_L(0); PG8_MMA(1, 0, At, B0); PG8_BAR; PG8_SCHED;
            PG8_STAGE(PG8_SB(1, 1), b3 + hstep, voffB);
            PG8_WAIT_V(6); PG8_BAR; PG8_MMA(1, 1, At, B1); PG8_BAR;
        }
        PG8_STAMP();
        if constexpr (!Epi::AFTER_DRAIN) { E(acc, cur, wr, wc, fr, fq); S.done(cur); }
        PG8_STAMP();
        if (!has_next) break;
#pragma unroll
        for (int a = 0; a < 2; ++a)
#pragma unroll
            for (int b = 0; b < 2; ++b)
#pragma unroll
                for (int m = 0; m < 4; ++m)
#pragma unroll
                    for (int n = 0; n < 2; ++n) acc[a][b][m][n] = (f32x4){0.f, 0.f, 0.f, 0.f};
        cur = nxt; cA = nA; cB = nB; ++ui;
    }
    PG8_WAIT_V(0);
    if (wr == 0) PG8_BAR;
    PG8_BAR;
    if constexpr (Epi::AFTER_DRAIN) { E.fused(acc, cur, wr, wc, fr, fq, lds, wid, lane); S.done(cur); }
    PG8_STAMP();
    if (STAMP && wid == 0) { stamps[lane] = lane < nts ? (((unsigned long long)(unsigned)ts_hi << 32) | (unsigned)ts_lo) : 0ull;
        if (lane == 62) stamps[62] = rt_entry; if (lane == 63) stamps[63] = (unsigned long long)wall_clock64(); }
#undef PG8_STAMP
#undef PG8_SA
#undef PG8_SB
#undef PG8_STAGE
#undef PG8_LDA
#undef PG8_LDB
#undef PG8_MMA
#undef PG8_WAIT_V
#undef PG8_WAIT_L
#undef PG8_BAR
#undef PG8_SCHED
}
}

namespace mk {
using pg8::bf16_t; using pg8::bf16x8; using pg8::f32x4; using pg8::u32x4; using pg8::Unit; using pg8::Gemm; using pg8::StaticOrder; using pg8::cvt_pk_bf16;
typedef short s16x4 __attribute__((ext_vector_type(4)));
typedef float f32x16 __attribute__((ext_vector_type(16)));
#define LAS __attribute__((address_space(3)))

#define XB_TMO      128
#define XB_XCNT(j)  (256  + 64 * (j))
#define XB_XSUB(j)  (1280 + 64 * (j))
#define XB_XGEN(j)  (2304 + 64 * (j))
#define XB_TOP      3328
#define XB_TOPGEN   3392
#define XCD_BAR_WORDS 3456
#define XB_SPIN_CAP (1u << 18)

__device__ __forceinline__ unsigned xb_ld(unsigned* p)              { return __hip_atomic_load(p, __ATOMIC_RELAXED, __HIP_MEMORY_SCOPE_AGENT); }
__device__ __forceinline__ unsigned xb_add(unsigned* p, unsigned v) { return __hip_atomic_fetch_add(p, v, __ATOMIC_RELAXED, __HIP_MEMORY_SCOPE_AGENT); }
__device__ __forceinline__ unsigned xb_xcc_id() { return (unsigned)__builtin_amdgcn_s_getreg((3 << 11) | 20) & 0xFu; }
#define XB_SPIN(cond, bar) do { unsigned _sp = 0; while (cond) { __builtin_amdgcn_s_sleep(1); \
    if ((++_sp & 255u) == 0u) { if (xb_ld(&(bar)[XB_TMO])) break; if (_sp > XB_SPIN_CAP) { atomicAdd(&(bar)[XB_TMO], 1u); break; } } } } while (0)

struct XcdBarrier {
    unsigned* bar; unsigned x;
    volatile LAS unsigned* st;
};

__device__ __forceinline__ XcdBarrier xcd_barrier_post(unsigned* bar, volatile LAS unsigned* st) {
    XcdBarrier b; b.bar = bar; b.x = xb_xcc_id(); b.st = st;
    if (threadIdx.x == 0) (void)xb_add(&bar[XB_XCNT(b.x)], 1u);
    return b;
}
__device__ __forceinline__ void xcd_barrier_complete(unsigned* bar, unsigned x, unsigned& nloc, unsigned& nx) {
    const unsigned G = gridDim.x * gridDim.y * gridDim.z;
    unsigned sum, cnt, mine, sp = 0u;
    for (;;) {
        sum = 0u; cnt = 0u; mine = 0u;
#pragma unroll
        for (unsigned j = 0; j < 16; ++j) { const unsigned c = xb_ld(&bar[XB_XCNT(j)]); sum += c; cnt += (c > 0u) ? 1u : 0u; mine = (j == x) ? c : mine; }
        if (sum == G) break;
        __builtin_amdgcn_s_sleep(1);
        if ((++sp & 255u) == 0u) { if (xb_ld(&bar[XB_TMO])) break; if (sp > XB_SPIN_CAP) { atomicAdd(&bar[XB_TMO], 1u); break; } }
    }
    nloc = mine > 0u ? mine : 1u; nx = cnt > 0u ? cnt : 1u;
}

__device__ __forceinline__ void xcd_barrier(const XcdBarrier& b) {
    asm volatile("s_waitcnt vmcnt(0)" ::: "memory");
    __syncthreads();
    if (threadIdx.x == 0) {
        unsigned* bar = b.bar;
        __builtin_amdgcn_s_waitcnt(0);
        unsigned nloc = b.st[0], nx = b.st[1];
        if (nloc == 0u) { xcd_barrier_complete(bar, b.x, nloc, nx); b.st[0] = nloc; b.st[1] = nx; }
        const unsigned old = xb_add(&bar[XB_XSUB(b.x)], 1u);
        const unsigned gen = old / nloc;
        if (old + 1u == (gen + 1u) * nloc) {
            __builtin_amdgcn_fence(__ATOMIC_RELEASE, "agent");
            asm volatile("s_waitcnt vmcnt(0)" ::: "memory");
            const unsigned og = xb_add(&bar[XB_TOP], 1u);
            const unsigned tg = og / nx;
            if (og + 1u == (tg + 1u) * nx) xb_add(&bar[XB_TOPGEN], 1u);
            else XB_SPIN(xb_ld(&bar[XB_TOPGEN]) == tg, bar);
            __builtin_amdgcn_fence(__ATOMIC_ACQUIRE, "agent");
            xb_add(&bar[XB_XGEN(b.x)], 1u);
            asm volatile("s_waitcnt vmcnt(0)" ::: "memory");
        } else {
            XB_SPIN(xb_ld(&bar[XB_XGEN(b.x)]) == gen, bar);
            __builtin_amdgcn_fence(__ATOMIC_ACQUIRE, "agent");
            asm volatile("s_waitcnt vmcnt(0)" ::: "memory");
        }
    }
    __syncthreads();
}


constexpr int SEQ = 4096, DM = 1024, DI = 2048, GSEQ = 8, MR = GSEQ * SEQ, NROUND = 3;
constexpr size_t LDS_BYTES = 136 * 1024;
constexpr size_t OFF_WIN_DA = 0, OFF_WOUT_DA = OFF_WIN_DA + (size_t)8192 * 1024 * 2, OFF_WIN_RET = OFF_WOUT_DA + (size_t)1024 * 2048 * 2,
                 OFF_WOUT_RET = OFF_WIN_RET + (size_t)6144 * 1024 * 2, OFF_TAB = OFF_WOUT_RET + (size_t)1024 * 2048 * 2,
                 OFF_H = OFF_TAB + (size_t)4 * 4096 * 64 * 4, OFF_BIG = OFF_H + (size_t)MR * DM * 2;
constexpr size_t SZ_2048 = (size_t)MR * 2048 * 2, SZ_1024 = (size_t)MR * 1024 * 2;
constexpr size_t OFF_D0 = OFF_BIG + (size_t)5 * ((size_t)MR * 2048 * 2) + 1048576, OFF_D1 = OFF_D0 + (size_t)3 * MR * DM * 2, OFF_BAR = OFF_D1 + (size_t)MR * DM * 2;
constexpr size_t OFF_RQ = OFF_BIG, OFF_RK = OFF_RQ + SZ_1024, OFF_RV = OFF_RK + SZ_1024, OFF_RG = OFF_RV + SZ_2048, OFF_SF = OFF_RG + SZ_2048, OFF_SB = OFF_SF + SZ_2048;

struct Params {
    const float* x_prompt; const float* x_sample; const float* norm_g; const float* da_w_in; const float* lq1; const float* lk1; const float* lq2; const float* lk2;
    const float* da_subln_g; const float* da_w_out; const float* ret_w_in; const float* ret_decay_fwd; const float* ret_decay_bwd; const float* ret_subln_g;
    const float* ret_w_out; const float* final_norm_g; float* out; unsigned char* ws;
};

__device__ __forceinline__ unsigned short f2bf(float f) { unsigned u = __float_as_uint(f); u += 0x7FFFu + ((u >> 16) & 1u); return (unsigned short)(u >> 16); }
__device__ __forceinline__ float bflo(unsigned w) { return __uint_as_float(w << 16); }
__device__ __forceinline__ float bfhi(unsigned w) { return __uint_as_float(w & 0xffff0000u); }
__device__ __forceinline__ bf16x8 scale8(bf16x8 x, float f) {
    u32x4 w = *reinterpret_cast<u32x4*>(&x); u32x4 r;
    r.x = cvt_pk_bf16(bflo(w.x) * f, bfhi(w.x) * f); r.y = cvt_pk_bf16(bflo(w.y) * f, bfhi(w.y) * f);
    r.z = cvt_pk_bf16(bflo(w.z) * f, bfhi(w.z) * f); r.w = cvt_pk_bf16(bflo(w.w) * f, bfhi(w.w) * f);
    return *reinterpret_cast<bf16x8*>(&r);
}
#define MK_BAR() do { asm volatile("" ::: "memory"); __builtin_amdgcn_s_barrier(); asm volatile("" ::: "memory"); } while (0)
#define SBAR() __builtin_amdgcn_sched_barrier(0)
#define KSWZ(row, colB) ((row) * 256 + ((colB) ^ (((row) & 7) << 4)))
__device__ __forceinline__ int crow(int r, int hi) { return (r & 3) + 8 * (r >> 2) + 4 * hi; }
template <int NCG> __device__ __forceinline__ int v_st(int k, int c) { const int kk = (k & ~0xC) | ((k & 4) << 1) | ((k & 8) >> 1); return ((kk >> 3) * NCG + (c >> 5)) * 512 + ((kk & 7) * 32 + (c & 31)) * 2; }
__device__ __forceinline__ int v_rd_base(int lane) { return ((lane & 3) << 3) | (((lane >> 2) & 3) << 6) | (((lane >> 4) & 1) << 5) | (((lane >> 5) & 1) << 8); }
template <int OFF> __device__ __forceinline__ s16x4 tr_read(unsigned vb) {
    s16x4 r; asm volatile("ds_read_b64_tr_b16 %0, %1 offset:%2" : "=&v"(r) : "v"(vb), "i"(OFF) : "memory"); return r;
}
#define PKLH(L, H) (bf16x8){L[0], L[1], L[2], L[3], H[0], H[1], H[2], H[3]}
#define PK4(P, BASE, OUT) do { unsigned a0 = cvt_pk_bf16(P[BASE + 0], P[BASE + 1]), a1 = cvt_pk_bf16(P[BASE + 2], P[BASE + 3]);   \
    unsigned b0 = cvt_pk_bf16(P[BASE + 4], P[BASE + 5]), b1 = cvt_pk_bf16(P[BASE + 6], P[BASE + 7]);                              \
    auto r0 = __builtin_amdgcn_permlane32_swap(a0, b0, false, false); auto r1 = __builtin_amdgcn_permlane32_swap(a1, b1, false, false); \
    u32x4 w_ = {r0[0], r1[0], r0[1], r1[1]}; OUT = *reinterpret_cast<bf16x8*>(&w_); } while (0)

__device__ __forceinline__ void transpose_tile(const float* __restrict__ W, bf16_t* __restrict__ Wt, int K, int N, bool permDA, int tile, LAS float* t) {
    const int ntn = N / 64, kt = tile / ntn, nt = tile % ntn, k0 = kt * 64, n0 = nt * 64, tid = mk_opaque_tid();
#pragma unroll
    for (int i = 0; i < 8; ++i) { const int k = i * 8 + (tid >> 6), n = tid & 63; t[k * 65 + n] = W[(size_t)(k0 + k) * N + n0 + n]; }
    __syncthreads();
#pragma unroll
    for (int i = 0; i < 8; ++i) { const int n = i * 8 + (tid >> 6), k = tid & 63; const int ns = n0 + n; int nd = ns;
        if (permDA && ns < 4096) { const int d = ns & 127; nd = (ns & ~127) + (d < 64 ? 2 * d : 2 * (d - 64) + 1); }
        Wt[(size_t)nd * K + k0 + k] = f2bf(t[k * 65 + n]); }
    __syncthreads();
}
__device__ __forceinline__ void prep_phase(const Params& P, LAS unsigned char* lds) {
    LAS float* t = (LAS float*)lds;
    bf16_t* w0 = (bf16_t*)(P.ws + OFF_WIN_DA); bf16_t* w1 = (bf16_t*)(P.ws + OFF_WOUT_DA); bf16_t* w2 = (bf16_t*)(P.ws + OFF_WIN_RET); bf16_t* w3 = (bf16_t*)(P.ws + OFF_WOUT_RET);
    constexpr int T0 = 16 * 128, T1 = 32 * 16, T2 = 16 * 96, T3 = 32 * 16;
    for (int i = blockIdx.x; i < T0 + T1 + T2 + T3; i += gridDim.x) {
        if (i < T0) transpose_tile(P.da_w_in, w0, 1024, 8192, true, i, t);
        else if (i < T0 + T1) transpose_tile(P.da_w_out, w1, 2048, 1024, false, i - T0, t);
        else if (i < T0 + T1 + T2) transpose_tile(P.ret_w_in, w2, 1024, 6144, false, i - T0 - T1, t);
        else transpose_tile(P.ret_w_out, w3, 2048, 1024, false, i - T0 - T1 - T2, t);
    }
    float* tab = (float*)(P.ws + OFF_TAB);
    for (int idx = blockIdx.x * 512 + threadIdx.x; idx < 2 * 4096 * 64; idx += gridDim.x * 512) {
        const int which = idx >> 18, e = idx & 262143, pos = e >> 6, i = e & 63;
        const double ex = which ? (double)i / 63.0 : (double)i / 64.0;
        const float inv = (float)exp(-ex * 9.210340371976184);
        const float ang = (float)pos * inv;
        double rev = (double)ang * 0.15915494309189535; rev -= rint(rev);
        const float rr = (float)(rev * 6.283185307179586);
        tab[(size_t)(which * 2) * 262144 + e] = __cosf(rr); tab[(size_t)(which * 2 + 1) * 262144 + e] = __sinf(rr);
    }
}

__device__ __forceinline__ void norm_to_bf16(const float* __restrict__ X, const float* __restrict__ g, bf16_t* __restrict__ H, int rows) {
    const int tid_ = mk_opaque_tid(), lane = tid_ & 63, gw = blockIdx.x * 8 + (tid_ >> 6), nw = gridDim.x * 8;
    f32x4 gv[4];
#pragma unroll
    for (int j = 0; j < 4; ++j) gv[j] = *(const f32x4*)(g + j * 256 + lane * 4);
    for (int r0 = gw; r0 < rows; r0 += 4 * nw) {
        f32x4 v[4][4];
#pragma unroll
        for (int q = 0; q < 4; ++q)
#pragma unroll
            for (int j = 0; j < 4; ++j) v[q][j] = __builtin_nontemporal_load((const f32x4*)(X + (size_t)(r0 + q * nw) * DM + j * 256 + lane * 4));
#pragma unroll
        for (int q = 0; q < 4; ++q) { float ss = 0.f;
#pragma unroll
            for (int j = 0; j < 4; ++j) ss += v[q][j][0] * v[q][j][0] + v[q][j][1] * v[q][j][1] + v[q][j][2] * v[q][j][2] + v[q][j][3] * v[q][j][3];
#pragma unroll
            for (int o = 32; o >= 1; o >>= 1) ss += __shfl_xor(ss, o);
            const float rs = rsqrtf(ss * (1.0f / DM) + 1e-6f);
#pragma unroll
            for (int j = 0; j < 4; ++j) { uint2 w; w.x = cvt_pk_bf16(v[q][j][0] * rs * gv[j][0], v[q][j][1] * rs * gv[j][1]); w.y = cvt_pk_bf16(v[q][j][2] * rs * gv[j][2], v[q][j][3] * rs * gv[j][3]);
                *(uint2*)(H + (size_t)(r0 + q * nw) * DM + j * 256 + lane * 4) = w; } }
    }
}
__device__ __forceinline__ void norm_inplace_f32(float* __restrict__ X, const float* __restrict__ g, int rows) {
    const int tid_ = mk_opaque_tid(), lane = tid_ & 63, gw = blockIdx.x * 8 + (tid_ >> 6), nw = gridDim.x * 8;
    f32x4 gv[4];
#pragma unroll
    for (int j = 0; j < 4; ++j) gv[j] = *(const f32x4*)(g + j * 256 + lane * 4);
    for (int r0 = gw; r0 < rows; r0 += 4 * nw) {
        f32x4 v[4][4];
#pragma unroll
        for (int q = 0; q < 4; ++q)
#pragma unroll
            for (int j = 0; j < 4; ++j) v[q][j] = *(const f32x4*)(X + (size_t)(r0 + q * nw) * DM + j * 256 + lane * 4);
#pragma unroll
        for (int q = 0; q < 4; ++q) { float ss = 0.f;
#pragma unroll
            for (int j = 0; j < 4; ++j) ss += v[q][j][0] * v[q][j][0] + v[q][j][1] * v[q][j][1] + v[q][j][2] * v[q][j][2] + v[q][j][3] * v[q][j][3];
#pragma unroll
            for (int o = 32; o >= 1; o >>= 1) ss += __shfl_xor(ss, o);
            const float rs = rsqrtf(ss * (1.0f / DM) + 1e-6f);
#pragma unroll
            for (int j = 0; j < 4; ++j) { f32x4 y = {v[q][j][0] * rs * gv[j][0], v[q][j][1] * rs * gv[j][1], v[q][j][2] * rs * gv[j][2], v[q][j][3] * rs * gv[j][3]}; *(f32x4*)(X + (size_t)(r0 + q * nw) * DM + j * 256 + lane * 4) = y; } }
    }
}

__device__ __forceinline__ void comb_norm_to_bf16(const float* __restrict__ Xin, const bf16_t* __restrict__ D, float* __restrict__ Xout, const float* __restrict__ g, bf16_t* __restrict__ H, int rows) {
    const int tid_ = mk_opaque_tid(), lane = tid_ & 63, gw = blockIdx.x * 8 + (tid_ >> 6), nw = gridDim.x * 8;
    f32x4 gv[4];
#pragma unroll
    for (int j = 0; j < 4; ++j) gv[j] = *(const f32x4*)(g + j * 256 + lane * 4);
    for (int r0 = gw; r0 < rows; r0 += 4 * nw) {
        f32x4 v[4][4]; uint2 d[4][4];
#pragma unroll
        for (int q = 0; q < 4; ++q)
#pragma unroll
            for (int j = 0; j < 4; ++j) { const size_t o = (size_t)(r0 + q * nw) * DM + j * 256 + lane * 4; v[q][j] = __builtin_nontemporal_load((const f32x4*)(Xin + o)); d[q][j] = *(const uint2*)(D + o); }
#pragma unroll
        for (int q = 0; q < 4; ++q) { float ss = 0.f;
#pragma unroll
            for (int j = 0; j < 4; ++j) { v[q][j][0] += bflo(d[q][j].x); v[q][j][1] += bfhi(d[q][j].x); v[q][j][2] += bflo(d[q][j].y); v[q][j][3] += bfhi(d[q][j].y);
                ss += v[q][j][0] * v[q][j][0] + v[q][j][1] * v[q][j][1] + v[q][j][2] * v[q][j][2] + v[q][j][3] * v[q][j][3]; }
#pragma unroll
            for (int o = 32; o >= 1; o >>= 1) ss += __shfl_xor(ss, o);
            const float rs = rsqrtf(ss * (1.0f / DM) + 1e-6f);
#pragma unroll
            for (int j = 0; j < 4; ++j) { const size_t o = (size_t)(r0 + q * nw) * DM + j * 256 + lane * 4; if (Xout) *(f32x4*)(Xout + o) = v[q][j];
                uint2 w; w.x = cvt_pk_bf16(v[q][j][0] * rs * gv[j][0], v[q][j][1] * rs * gv[j][1]); w.y = cvt_pk_bf16(v[q][j][2] * rs * gv[j][2], v[q][j][3] * rs * gv[j][3]);
                *(uint2*)(H + o) = w; } }
    }
}
__device__ __forceinline__ void comb_norm_inplace_f32(float* __restrict__ X, const bf16_t* __restrict__ D, const float* __restrict__ g, int rows) {
    const int tid_ = mk_opaque_tid(), lane = tid_ & 63, gw = blockIdx.x * 8 + (tid_ >> 6), nw = gridDim.x * 8;
    f32x4 gv[4];
#pragma unroll
    for (int j = 0; j < 4; ++j) gv[j] = *(const f32x4*)(g + j * 256 + lane * 4);
    for (int r0 = gw; r0 < rows; r0 += 4 * nw) {
        f32x4 v[4][4]; uint2 d[4][4];
#pragma unroll
        for (int q = 0; q < 4; ++q)
#pragma unroll
            for (int j = 0; j < 4; ++j) { const size_t o = (size_t)(r0 + q * nw) * DM + j * 256 + lane * 4; v[q][j] = *(const f32x4*)(X + o); d[q][j] = *(const uint2*)(D + o); }
#pragma unroll
        for (int q = 0; q < 4; ++q) { float ss = 0.f;
#pragma unroll
            for (int j = 0; j < 4; ++j) { v[q][j][0] += bflo(d[q][j].x); v[q][j][1] += bfhi(d[q][j].x); v[q][j][2] += bflo(d[q][j].y); v[q][j][3] += bfhi(d[q][j].y);
                ss += v[q][j][0] * v[q][j][0] + v[q][j][1] * v[q][j][1] + v[q][j][2] * v[q][j][2] + v[q][j][3] * v[q][j][3]; }
#pragma unroll
            for (int o = 32; o >= 1; o >>= 1) ss += __shfl_xor(ss, o);
            const float rs = rsqrtf(ss * (1.0f / DM) + 1e-6f);
#pragma unroll
            for (int j = 0; j < 4; ++j) { f32x4 y = {v[q][j][0] * rs * gv[j][0], v[q][j][1] * rs * gv[j][1], v[q][j][2] * rs * gv[j][2], v[q][j][3] * rs * gv[j][3]}; *(f32x4*)(X + (size_t)(r0 + q * nw) * DM + j * 256 + lane * 4) = y; } }
    }
}

__device__ __forceinline__ void comb2_norm_out(const float* __restrict__ Xin, const bf16_t* __restrict__ Da, const bf16_t* __restrict__ Db, const float* __restrict__ g, float* __restrict__ Out, int rows) {
    const int tid_ = mk_opaque_tid(), lane = tid_ & 63, gw = blockIdx.x * 8 + (tid_ >> 6), nw = gridDim.x * 8;
    f32x4 gv[4];
#pragma unroll
    for (int j = 0; j < 4; ++j) gv[j] = *(const f32x4*)(g + j * 256 + lane * 4);
    for (int r0 = gw; r0 < rows; r0 += 4 * nw) {
        f32x4 v[4][4]; uint2 da[4][4], db[4][4];
#pragma unroll
        for (int q = 0; q < 4; ++q)
#pragma unroll
            for (int j = 0; j < 4; ++j) { const size_t o = (size_t)(r0 + q * nw) * DM + j * 256 + lane * 4; v[q][j] = __builtin_nontemporal_load((const f32x4*)(Xin + o)); { typedef unsigned u32x2v_ __attribute__((ext_vector_type(2))); const u32x2v_ ta = __builtin_nontemporal_load((const u32x2v_*)(Da + o)), tb = __builtin_nontemporal_load((const u32x2v_*)(Db + o)); da[q][j].x = ta[0]; da[q][j].y = ta[1]; db[q][j].x = tb[0]; db[q][j].y = tb[1]; } }
#pragma unroll
        for (int q = 0; q < 4; ++q) { float ss = 0.f;
#pragma unroll
            for (int j = 0; j < 4; ++j) { v[q][j][0] += bflo(da[q][j].x) + bflo(db[q][j].x); v[q][j][1] += bfhi(da[q][j].x) + bfhi(db[q][j].x); v[q][j][2] += bflo(da[q][j].y) + bflo(db[q][j].y); v[q][j][3] += bfhi(da[q][j].y) + bfhi(db[q][j].y);
                ss += v[q][j][0] * v[q][j][0] + v[q][j][1] * v[q][j][1] + v[q][j][2] * v[q][j][2] + v[q][j][3] * v[q][j][3]; }
#pragma unroll
            for (int o = 32; o >= 1; o >>= 1) ss += __shfl_xor(ss, o);
            const float rs = rsqrtf(ss * (1.0f / DM) + 1e-6f);
#pragma unroll
            for (int j = 0; j < 4; ++j) { f32x4 y = {v[q][j][0] * rs * gv[j][0], v[q][j][1] * rs * gv[j][1], v[q][j][2] * rs * gv[j][2], v[q][j][3] * rs * gv[j][3]}; __builtin_nontemporal_store(y, (f32x4*)(Out + (size_t)(r0 + q * nw) * DM + j * 256 + lane * 4)); } }
    }
}

__device__ __forceinline__ u32x4 rot_pack(f32x4 v0, f32x4 v1, const float* tc, const float* ts, float sc) {
    const f32x4 c = *(const f32x4*)tc, s = *(const f32x4*)ts; u32x4 w;
    w.x = cvt_pk_bf16((v0[0] * c[0] - v0[1] * s[0]) * sc, (v0[1] * c[0] + v0[0] * s[0]) * sc);
    w.y = cvt_pk_bf16((v0[2] * c[1] - v0[3] * s[1]) * sc, (v0[3] * c[1] + v0[2] * s[1]) * sc);
    w.z = cvt_pk_bf16((v1[0] * c[2] - v1[1] * s[2]) * sc, (v1[1] * c[2] + v1[0] * s[2]) * sc);
    w.w = cvt_pk_bf16((v1[2] * c[3] - v1[3] * s[3]) * sc, (v1[3] * c[3] + v1[2] * s[3]) * sc);
    return w;
}
__device__ __forceinline__ u32x4 plain_pack(f32x4 v0, f32x4 v1) { u32x4 w; w.x = cvt_pk_bf16(v0[0], v0[1]); w.y = cvt_pk_bf16(v0[2], v0[3]); w.z = cvt_pk_bf16(v1[0], v1[1]); w.w = cvt_pk_bf16(v1[2], v1[3]); return w; }

struct EpiDA {
    static constexpr bool PERM = true, AFTER_DRAIN = false;
    bf16_t* big; const float* tcos; const float* tsin;
    __device__ __forceinline__ void operator()(const f32x4 (&acc)[2][2][4][2], const Unit& u, int wr, int wc, int fr, int fq) const {
        const int region = u.pn >> 3; bf16_t* base = big + (size_t)region * ((size_t)MR * 2048);
        const int colr0 = (u.pn & 7) * 256 + wc * 32 + 8 * fq, row0 = u.pm * 256 + wr * 64 + fr;
        if (region < 2) {
            const int i0 = (colr0 & 127) >> 1; const float sc = region == 0 ? 0.08838834764831845f : 1.0f;
            f32x4 cs[8], sn[8];
#pragma unroll
            for (int q = 0; q < 8; ++q) { const int pos = (row0 + (q >> 2) * 128 + (q & 3) * 16) & (SEQ - 1); cs[q] = *(const f32x4*)(tcos + pos * 64 + i0); sn[q] = *(const f32x4*)(tsin + pos * 64 + i0); }
            asm volatile("" ::: "memory");
#pragma unroll
            for (int q = 0; q < 8; ++q) { const int ai = q >> 2, m = q & 3, row = row0 + ai * 128 + m * 16; const f32x4 c = cs[q], s = sn[q];
#pragma unroll
                for (int bj = 0; bj < 2; ++bj) { const f32x4 v0 = acc[ai][bj][m][0], v1 = acc[ai][bj][m][1]; u32x4 w;
                    w.x = cvt_pk_bf16((v0[0] * c[0] - v0[1] * s[0]) * sc, (v0[1] * c[0] + v0[0] * s[0]) * sc);
                    w.y = cvt_pk_bf16((v0[2] * c[1] - v0[3] * s[1]) * sc, (v0[3] * c[1] + v0[2] * s[1]) * sc);
                    w.z = cvt_pk_bf16((v1[0] * c[2] - v1[1] * s[2]) * sc, (v1[1] * c[2] + v1[0] * s[2]) * sc);
                    w.w = cvt_pk_bf16((v1[2] * c[3] - v1[3] * s[3]) * sc, (v1[3] * c[3] + v1[2] * s[3]) * sc);
                    *(u32x4*)(base + (size_t)row * 2048 + colr0 + bj * 128) = w; } }
        } else {
#pragma unroll
            for (int ai = 0; ai < 2; ++ai)
#pragma unroll
                for (int m = 0; m < 4; ++m) { const int row = row0 + ai * 128 + m * 16;
#pragma unroll
                    for (int bj = 0; bj < 2; ++bj) *(u32x4*)(base + (size_t)row * 2048 + colr0 + bj * 128) = plain_pack(acc[ai][bj][m][0], acc[ai][bj][m][1]); }
        }
    }
};
struct EpiRET {
    static constexpr bool PERM = true, AFTER_DRAIN = false;
    bf16_t* rq; bf16_t* rk; bf16_t* rv; bf16_t* rg; const float* tcos; const float* tsin;
    __device__ __forceinline__ void operator()(const f32x4 (&acc)[2][2][4][2], const Unit& u, int wr, int wc, int fr, int fq) const {
        const bool isrot = u.pn < 8; bf16_t* base; int ld, colt;
        if (u.pn < 4) { base = rq; ld = 1024; colt = u.pn * 256; } else if (u.pn < 8) { base = rk; ld = 1024; colt = (u.pn - 4) * 256; }
        else if (u.pn < 16) { base = rv; ld = 2048; colt = (u.pn - 8) * 256; } else { base = rg; ld = 2048; colt = (u.pn - 16) * 256; }
        const int colr0 = colt + wc * 32 + 8 * fq, row0 = u.pm * 256 + wr * 64 + fr;
        if (isrot) {
            const int i0 = (colr0 & 127) >> 1; const float sc = u.pn >= 4 ? 0.08838834764831845f : 1.0f;
            f32x4 cs[8], sn[8];
#pragma unroll
            for (int q = 0; q < 8; ++q) { const int pos = (row0 + (q >> 2) * 128 + (q & 3) * 16) & (SEQ - 1); cs[q] = *(const f32x4*)(tcos + pos * 64 + i0); sn[q] = *(const f32x4*)(tsin + pos * 64 + i0); }
            asm volatile("" ::: "memory");
#pragma unroll
            for (int q = 0; q < 8; ++q) { const int ai = q >> 2, m = q & 3, row = row0 + ai * 128 + m * 16; const f32x4 c = cs[q], s = sn[q];
#pragma unroll
                for (int bj = 0; bj < 2; ++bj) { const f32x4 v0 = acc[ai][bj][m][0], v1 = acc[ai][bj][m][1]; u32x4 w;
                    w.x = cvt_pk_bf16((v0[0] * c[0] - v0[1] * s[0]) * sc, (v0[1] * c[0] + v0[0] * s[0]) * sc);
                    w.y = cvt_pk_bf16((v0[2] * c[1] - v0[3] * s[1]) * sc, (v0[3] * c[1] + v0[2] * s[1]) * sc);
                    w.z = cvt_pk_bf16((v1[0] * c[2] - v1[1] * s[2]) * sc, (v1[1] * c[2] + v1[0] * s[2]) * sc);
                    w.w = cvt_pk_bf16((v1[2] * c[3] - v1[3] * s[3]) * sc, (v1[3] * c[3] + v1[2] * s[3]) * sc);
                    *(u32x4*)(base + (size_t)row * ld + colr0 + bj * 128) = w; } }
        } else {
#pragma unroll
            for (int ai = 0; ai < 2; ++ai)
#pragma unroll
                for (int m = 0; m < 4; ++m) { const int row = row0 + ai * 128 + m * 16;
#pragma unroll
                    for (int bj = 0; bj < 2; ++bj) *(u32x4*)(base + (size_t)row * ld + colr0 + bj * 128) = plain_pack(acc[ai][bj][m][0], acc[ai][bj][m][1]); }
        }
    }
};
struct EpiRes {
    static constexpr bool PERM = false, AFTER_DRAIN = false;
    float* out; const float* res;
    __device__ __forceinline__ void operator()(const f32x4 (&acc)[2][2][4][2], const Unit& u, int wr, int wc, int fr, int fq) const {
        const int row0 = u.pm * 256 + wr * 64 + fr, col0 = u.pn * 256 + wc * 32 + 4 * fq;
#pragma unroll
        for (int ai = 0; ai < 2; ++ai) {
            f32x4 r[4][2][2];
#pragma unroll
            for (int m = 0; m < 4; ++m)
#pragma unroll
                for (int bj = 0; bj < 2; ++bj)
#pragma unroll
                    for (int n = 0; n < 2; ++n) r[m][bj][n] = *(const f32x4*)(res + (size_t)(row0 + ai * 128 + m * 16) * DM + col0 + bj * 128 + n * 16);
            asm volatile("" ::: "memory");
#pragma unroll
            for (int m = 0; m < 4; ++m)
#pragma unroll
                for (int bj = 0; bj < 2; ++bj)
#pragma unroll
                    for (int n = 0; n < 2; ++n) *(f32x4*)(out + (size_t)(row0 + ai * 128 + m * 16) * DM + col0 + bj * 128 + n * 16) = acc[ai][bj][m][n] + r[m][bj][n];
        }
    }
};
struct EpiDelta {
    static constexpr bool PERM = true, AFTER_DRAIN = false;
    bf16_t* D;
    __device__ __forceinline__ void operator()(const f32x4 (&acc)[2][2][4][2], const Unit& u, int wr, int wc, int fr, int fq) const {
        const int colr0 = u.pn * 256 + wc * 32 + 8 * fq, row0 = u.pm * 256 + wr * 64 + fr;
#pragma unroll
        for (int ai = 0; ai < 2; ++ai)
#pragma unroll
            for (int m = 0; m < 4; ++m) { const int row = row0 + ai * 128 + m * 16;
#pragma unroll
                for (int bj = 0; bj < 2; ++bj) *(u32x4*)(D + (size_t)row * DM + colr0 + bj * 128) = plain_pack(acc[ai][bj][m][0], acc[ai][bj][m][1]); }
    }
};
template <class Epi> __device__ __forceinline__ void run_gemm(LAS unsigned char* lds, const bf16_t* A, const bf16_t* Bt, int M, int N, int K, const Epi& E) {
    Gemm g; g.A = A; g.Bt = Bt; g.M = M; g.N = N; g.K = K;
    StaticOrder S; S.init(M, N, (int)gridDim.x, (int)blockIdx.x);
    pg8::gemm_phase<Epi, StaticOrder, false>(lds, g, S, E, nullptr);
}

__device__ __forceinline__ void subln_gate_store(LAS unsigned char* lds, const float* __restrict__ g, float oscale, const bf16_t* __restrict__ gate, bf16_t* __restrict__ dst, int ld) {
    const int tid_ = mk_opaque_tid(), wid = tid_ >> 6, lane = tid_ & 63, cc = lane & 31;
    f32x4 g0 = *(const f32x4*)(g + cc * 8), g1 = *(const f32x4*)(g + cc * 8 + 4);
    u32x4 gt[8];
#pragma unroll
    for (int j = 0; j < 8; ++j) gt[j] = *(const u32x4*)(gate + (size_t)(16 * wid + 2 * j + (lane >> 5)) * ld + cc * 8);
    asm volatile("" ::: "memory");
#pragma unroll
    for (int j = 0; j < 8; ++j) {
        const int row = 16 * wid + 2 * j + (lane >> 5);
        const f32x4 a = *(const LAS f32x4*)(lds + (row * 256 + cc * 8) * 4), b = *(const LAS f32x4*)(lds + (row * 256 + cc * 8 + 4) * 4);
        float ss = a[0] * a[0] + a[1] * a[1] + a[2] * a[2] + a[3] * a[3] + b[0] * b[0] + b[1] * b[1] + b[2] * b[2] + b[3] * b[3];
#pragma unroll
        for (int o = 16; o >= 1; o >>= 1) ss += __shfl_xor(ss, o);
        const float rs = rsqrtf(ss * (1.0f / 256.0f) + 1e-5f) * oscale;
        float gg[8] = {bflo(gt[j].x), bfhi(gt[j].x), bflo(gt[j].y), bfhi(gt[j].y), bflo(gt[j].z), bfhi(gt[j].z), bflo(gt[j].w), bfhi(gt[j].w)};
        float y[8] = {a[0] * g0[0], a[1] * g0[1], a[2] * g0[2], a[3] * g0[3], b[0] * g1[0], b[1] * g1[1], b[2] * g1[2], b[3] * g1[3]};
#pragma unroll
        for (int e2 = 0; e2 < 8; ++e2) { const float sg = gg[e2] * __builtin_amdgcn_rcpf(1.0f + __expf(-gg[e2])); y[e2] = y[e2] * rs * sg; }
        u32x4 w; w.x = cvt_pk_bf16(y[0], y[1]); w.y = cvt_pk_bf16(y[2], y[3]); w.z = cvt_pk_bf16(y[4], y[5]); w.w = cvt_pk_bf16(y[6], y[7]);
        *(u32x4*)(dst + (size_t)row * ld + cc * 8) = w;
    }
}

constexpr float LOG2E = 1.4426950408889634f, ATHR = 8.0f;
__device__ __forceinline__ void partialSM(f32x16& p0, f32x16& p1, float& m_reg, float& mn, float& alpha) {
    float pmax = p0[0];
#pragma unroll
    for (int r = 1; r < 16; ++r) pmax = fmaxf(pmax, p0[r]);
#pragma unroll
    for (int r = 0; r < 16; ++r) pmax = fmaxf(pmax, p1[r]);
    { auto rr = __builtin_amdgcn_permlane32_swap(__float_as_uint(pmax), __float_as_uint(pmax), false, false); pmax = fmaxf(__uint_as_float(rr[0]), __uint_as_float(rr[1])); }
    if (__builtin_expect(__all(pmax - m_reg <= ATHR), 1)) { mn = m_reg; alpha = 1.f; }
    else { mn = fmaxf(m_reg, pmax); alpha = __builtin_amdgcn_exp2f((m_reg - mn) * LOG2E); m_reg = mn; }
    const float mnC = -mn * LOG2E;
#pragma unroll
    for (int r = 0; r < 16; ++r) p0[r] = __builtin_amdgcn_exp2f(fmaf(p0[r], LOG2E, mnC));
#pragma unroll
    for (int r = 0; r < 16; ++r) p1[r] = __builtin_amdgcn_exp2f(fmaf(p1[r], LOG2E, mnC));
}
__device__ __forceinline__ void finishSM(f32x16& p0, f32x16& p1, float alpha, float& l_reg, bf16x8& pa0, bf16x8& pa1, bf16x8& pa2, bf16x8& pa3) {
    float ps = 0;
#pragma unroll
    for (int r = 0; r < 16; ++r) ps += p0[r];
#pragma unroll
    for (int r = 0; r < 16; ++r) ps += p1[r];
    { auto rr = __builtin_amdgcn_permlane32_swap(__float_as_uint(ps), __float_as_uint(ps), false, false); ps = __uint_as_float(rr[0]) + __uint_as_float(rr[1]); }
    l_reg = l_reg * alpha + ps;
    PK4(p0, 0, pa0); PK4(p0, 8, pa1); PK4(p1, 0, pa2); PK4(p1, 8, pa3);
}
template <int D0> __device__ __forceinline__ void pv_one(f32x16& od, unsigned vb, bf16x8 pa0, bf16x8 pa1, bf16x8 pa2, bf16x8 pa3) {
    const s16x4 l0 = tr_read<D0 * 512 + 0 * 8192>(vb), h0 = tr_read<D0 * 512 + 0 * 8192 + 4096>(vb), l1 = tr_read<D0 * 512 + 1 * 8192>(vb), h1 = tr_read<D0 * 512 + 1 * 8192 + 4096>(vb);
    const s16x4 l2 = tr_read<D0 * 512 + 2 * 8192>(vb), h2 = tr_read<D0 * 512 + 2 * 8192 + 4096>(vb), l3 = tr_read<D0 * 512 + 3 * 8192>(vb), h3 = tr_read<D0 * 512 + 3 * 8192 + 4096>(vb);
    asm volatile("s_waitcnt lgkmcnt(0)" ::: "memory"); SBAR();
    od = __builtin_amdgcn_mfma_f32_32x32x16_bf16(pa0, PKLH(l0, h0), od, 0, 0, 0);
    od = __builtin_amdgcn_mfma_f32_32x32x16_bf16(pa1, PKLH(l1, h1), od, 0, 0, 0);
    od = __builtin_amdgcn_mfma_f32_32x32x16_bf16(pa2, PKLH(l2, h2), od, 0, 0, 0);
    od = __builtin_amdgcn_mfma_f32_32x32x16_bf16(pa3, PKLH(l3, h3), od, 0, 0, 0);
}

#define SBV() __builtin_amdgcn_sched_barrier(0x2 | 0x4 | 0x400)
__device__ __forceinline__ void smA(f32x16& p0, f32x16& p1, float& m_reg, float& alpha) {
    float pmax = p0[0];
#pragma unroll
    for (int r = 1; r < 16; ++r) pmax = fmaxf(pmax, p0[r]);
#pragma unroll
    for (int r = 0; r < 16; ++r) pmax = fmaxf(pmax, p1[r]);
    { auto rr = __builtin_amdgcn_permlane32_swap(__float_as_uint(pmax), __float_as_uint(pmax), false, false); pmax = fmaxf(__uint_as_float(rr[0]), __uint_as_float(rr[1])); }
    float mn;
    if (__builtin_expect(__all(pmax - m_reg <= ATHR), 1)) { mn = m_reg; alpha = 1.f; }
    else { mn = fmaxf(m_reg, pmax); alpha = __builtin_amdgcn_exp2f((m_reg - mn) * LOG2E); m_reg = mn; }
    const float mnC = -mn * LOG2E;
#pragma unroll
    for (int r = 0; r < 16; ++r) p0[r] = __builtin_amdgcn_exp2f(fmaf(p0[r], LOG2E, mnC));
#pragma unroll
    for (int r = 0; r < 16; ++r) p1[r] = fmaf(p1[r], LOG2E, mnC);
}
template <int D0, int KS0> __device__ __forceinline__ void pv_half(f32x16& oa, f32x16& ob, unsigned vb, bf16x8 paX, bf16x8 paY) {
    const s16x4 l0 = tr_read<D0 * 512 + KS0 * 8192>(vb), h0 = tr_read<D0 * 512 + KS0 * 8192 + 4096>(vb), l1 = tr_read<D0 * 512 + (KS0 + 1) * 8192>(vb), h1 = tr_read<D0 * 512 + (KS0 + 1) * 8192 + 4096>(vb);
    const s16x4 m0 = tr_read<(D0 + 1) * 512 + KS0 * 8192>(vb), n0 = tr_read<(D0 + 1) * 512 + KS0 * 8192 + 4096>(vb), m1 = tr_read<(D0 + 1) * 512 + (KS0 + 1) * 8192>(vb), n1 = tr_read<(D0 + 1) * 512 + (KS0 + 1) * 8192 + 4096>(vb);
    asm volatile("s_waitcnt lgkmcnt(0)" ::: "memory"); SBV();
    oa = __builtin_amdgcn_mfma_f32_32x32x16_bf16(paX, PKLH(l0, h0), oa, 0, 0, 0);
    oa = __builtin_amdgcn_mfma_f32_32x32x16_bf16(paY, PKLH(l1, h1), oa, 0, 0, 0);
    ob = __builtin_amdgcn_mfma_f32_32x32x16_bf16(paX, PKLH(m0, n0), ob, 0, 0, 0);
    ob = __builtin_amdgcn_mfma_f32_32x32x16_bf16(paY, PKLH(m1, n1), ob, 0, 0, 0);
}
__device__ __forceinline__ void attn_phase(const Params& P, LAS unsigned char* lds) {
    constexpr int NT = SEQ / 64;
    for (int it = blockIdx.x; it < GSEQ * 8 * 32; it += gridDim.x) {
        const int tid = mk_opaque_tid(), wid = __builtin_amdgcn_readfirstlane(tid >> 6), lane = tid & 63, r32 = lane & 31, hi = lane >> 5;
        const int map = wid >> 2, wq = wid & 3;
        bf16_t* qbuf = (bf16_t*)(P.ws + OFF_BIG); const bf16_t* kbuf = qbuf + (size_t)MR * 2048; const bf16_t* vbuf = kbuf + (size_t)MR * 2048; const bf16_t* gbuf = vbuf + (size_t)MR * 2048;
        const unsigned lds0 = (unsigned)(size_t)lds;
        LAS float* li_l = (LAS float*)(lds + 131072 + wid * 256); LAS float* al_l = li_l + 32;
        const unsigned kL = (unsigned)((4 * wid + (lane >> 4)) * 2048 + (((lane & 15) ^ (4 * (wid & 1) + (lane >> 4))) * 8)) * 2u;
        const unsigned vL = (unsigned)((8 * ((lane >> 4) & 1) + 4 * (wid >> 2) + ((lane >> 2) & 3)) * 2048 + (2 * (wid & 3) + (lane >> 5)) * 32 + (lane & 3) * 8) * 2u;
        const int head = it & 7, qblk = (it >> 3) & 31, seq = it >> 8;
        const size_t tok0 = (size_t)seq * SEQ;
        const char* kb = (const char*)(kbuf + tok0 * 2048 + (2 * head) * 128);
        const char* vb = (const char*)(vbuf + tok0 * 2048 + head * 256);
#define AT_PIECE(i, sbase, ko_, vo_) do { \
        if ((i) == 0) __builtin_amdgcn_global_load_lds((const unsigned*)(kb + (ko_)), (LAS unsigned*)(sbase), 16, 0, 0); \
        if ((i) == 1) __builtin_amdgcn_global_load_lds((const unsigned*)(kb + ((ko_) + 32u * 4096u)), (LAS unsigned*)((sbase) + 8192), 16, 0, 0); \
        if ((i) == 2) __builtin_amdgcn_global_load_lds((const unsigned*)(kb + ((ko_) + 256u)), (LAS unsigned*)((sbase) + 16384), 16, 0, 0); \
        if ((i) == 3) __builtin_amdgcn_global_load_lds((const unsigned*)(kb + ((ko_) + 256u + 32u * 4096u)), (LAS unsigned*)((sbase) + 16384 + 8192), 16, 0, 0); \
        if ((i) == 4) __builtin_amdgcn_global_load_lds((const unsigned*)(vb + (vo_)), (LAS unsigned*)((sbase) + 32768), 16, 0, 0); \
        if ((i) == 5) __builtin_amdgcn_global_load_lds((const unsigned*)(vb + ((vo_) + 16u * 4096u)), (LAS unsigned*)((sbase) + 32768 + 8192), 16, 0, 0); \
        if ((i) == 6) __builtin_amdgcn_global_load_lds((const unsigned*)(vb + ((vo_) + 32u * 4096u)), (LAS unsigned*)((sbase) + 32768 + 16384), 16, 0, 0); \
        if ((i) == 7) __builtin_amdgcn_global_load_lds((const unsigned*)(vb + ((vo_) + 48u * 4096u)), (LAS unsigned*)((sbase) + 32768 + 24576), 16, 0, 0); } while (0)
#define AT_ISSUE(st, k0) do { LAS unsigned char* s_ = lds + (st) * 65536 + wid * 1024; const unsigned ko_ = kL + (unsigned)(k0) * 4096u, vo_ = vL + (unsigned)(k0) * 4096u; \
        AT_PIECE(0, s_, ko_, vo_); AT_PIECE(1, s_, ko_, vo_); AT_PIECE(2, s_, ko_, vo_); AT_PIECE(3, s_, ko_, vo_); AT_PIECE(4, s_, ko_, vo_); AT_PIECE(5, s_, ko_, vo_); AT_PIECE(6, s_, ko_, vo_); AT_PIECE(7, s_, ko_, vo_); } while (0)
        const size_t qrow0 = tok0 + qblk * 128;
        bf16x8 qr[8];
        { const bf16_t* qp = qbuf + (qrow0 + wq * 32 + r32) * 2048 + (2 * head + map) * 128 + hi * 8;
#pragma unroll
          for (int d0 = 0; d0 < 8; ++d0) qr[d0] = *(const bf16x8*)(qp + d0 * 16); }
        AT_ISSUE(0, 0);
        asm volatile("s_waitcnt vmcnt(0)" ::: "memory"); MK_BAR();
        float m_reg = -1e30f, l_reg = 0.f; f32x16 o[8];
#pragma unroll
        for (int d = 0; d < 8; ++d) o[d] = f32x16{};
        for (int j = 0; j < NT; ++j) {
            const unsigned st = (unsigned)(j & 1) * 65536u;
            f32x16 p0 = f32x16{}, p1 = f32x16{};
            { const LAS unsigned char* Ks = lds + st + map * 16384;
              const bool more = j + 1 < NT;
              LAS unsigned char* sn_ = lds + (65536u - st) + wid * 1024; const unsigned kon_ = kL + (unsigned)(j + 1) * (64u * 4096u), von_ = vL + (unsigned)(j + 1) * (64u * 4096u);
#pragma unroll
              for (int d0 = 0; d0 < 8; ++d0) { const int cb = (d0 * 16 + hi * 8) * 2;
                  const bf16x8 b0 = *(const LAS bf16x8*)(Ks + KSWZ(r32, cb)); const bf16x8 b1 = *(const LAS bf16x8*)(Ks + 8192 + KSWZ(r32, cb));
                  p0 = __builtin_amdgcn_mfma_f32_32x32x16_bf16(b0, qr[d0], p0, 0, 0, 0);
                  p1 = __builtin_amdgcn_mfma_f32_32x32x16_bf16(b1, qr[d0], p1, 0, 0, 0);
                  if (more) AT_PIECE(d0, sn_, kon_, von_);
                  SBAR(); } }
            float al; smA(p0, p1, m_reg, al);
            if (__any(al < 1.f)) { if (hi == 0) al_l[r32] = al; asm volatile("s_waitcnt lgkmcnt(0)" ::: "memory");
#pragma unroll
                for (int r = 0; r < 16; ++r) { const float a = al_l[crow(r, hi)];
#pragma unroll
                    for (int d = 0; d < 8; ++d) o[d][r] *= a; } }
            bf16x8 pa0, pa1, pa2, pa3; float ps = 0.f;
#pragma unroll
            for (int r = 0; r < 16; ++r) ps += p0[r];
            PK4(p0, 0, pa0); PK4(p0, 8, pa1);
            const unsigned vb0 = lds0 + st + 32768u + (unsigned)v_rd_base(lane);
#define PVR(G, D0, KS0) const s16x4 G##l0 = tr_read<(D0) * 512 + (KS0) * 8192>(vb0), G##h0 = tr_read<(D0) * 512 + (KS0) * 8192 + 4096>(vb0), G##l1 = tr_read<(D0) * 512 + ((KS0) + 1) * 8192>(vb0), G##h1 = tr_read<(D0) * 512 + ((KS0) + 1) * 8192 + 4096>(vb0), \
                G##m0 = tr_read<((D0) + 1) * 512 + (KS0) * 8192>(vb0), G##n0 = tr_read<((D0) + 1) * 512 + (KS0) * 8192 + 4096>(vb0), G##m1 = tr_read<((D0) + 1) * 512 + ((KS0) + 1) * 8192>(vb0), G##n1 = tr_read<((D0) + 1) * 512 + ((KS0) + 1) * 8192 + 4096>(vb0)
#define PVM(G, OA, OB, PX, PY) do { asm volatile("s_waitcnt lgkmcnt(0)" ::: "memory"); SBAR(); \
                OA = __builtin_amdgcn_mfma_f32_32x32x16_bf16(PX, PKLH(G##l0, G##h0), OA, 0, 0, 0); OA = __builtin_amdgcn_mfma_f32_32x32x16_bf16(PY, PKLH(G##l1, G##h1), OA, 0, 0, 0); \
                OB = __builtin_amdgcn_mfma_f32_32x32x16_bf16(PX, PKLH(G##m0, G##n0), OB, 0, 0, 0); OB = __builtin_amdgcn_mfma_f32_32x32x16_bf16(PY, PKLH(G##m1, G##n1), OB, 0, 0, 0); } while (0)
            PVR(ga, 0, 0);
            PVM(ga, o[0], o[1], pa0, pa1); PVR(gb, 2, 0);
#pragma unroll
            for (int r = 0; r < 4; ++r) { p1[r] = __builtin_amdgcn_exp2f(p1[r]); ps += p1[r]; }
            PVM(gb, o[2], o[3], pa0, pa1); PVR(gc, 4, 0);
#pragma unroll
            for (int r = 4; r < 8; ++r) { p1[r] = __builtin_amdgcn_exp2f(p1[r]); ps += p1[r]; }
            PK4(p1, 0, pa2);
            PVM(gc, o[4], o[5], pa0, pa1); PVR(gd, 6, 0);
#pragma unroll
            for (int r = 8; r < 12; ++r) { p1[r] = __builtin_amdgcn_exp2f(p1[r]); ps += p1[r]; }
            PVM(gd, o[6], o[7], pa0, pa1); PVR(ge, 0, 2);
#pragma unroll
            for (int r = 12; r < 16; ++r) { p1[r] = __builtin_amdgcn_exp2f(p1[r]); ps += p1[r]; }
            PK4(p1, 8, pa3);
            { auto rr = __builtin_amdgcn_permlane32_swap(__float_as_uint(ps), __float_as_uint(ps), false, false); ps = __uint_as_float(rr[0]) + __uint_as_float(rr[1]); }
            l_reg = l_reg * al + ps;
            PVM(ge, o[0], o[1], pa2, pa3); PVR(gf, 2, 2);
            PVM(gf, o[2], o[3], pa2, pa3); PVR(gg, 4, 2);
            PVM(gg, o[4], o[5], pa2, pa3); PVR(gh, 6, 2);
            PVM(gh, o[6], o[7], pa2, pa3);
#undef PVR
#undef PVM
            asm volatile("s_waitcnt vmcnt(0)" ::: "memory"); MK_BAR();
        }
#undef AT_ISSUE
#undef AT_PIECE
        float lam;
        { float a = P.lq1[lane] * P.lk1[lane] + P.lq1[lane + 64] * P.lk1[lane + 64], b = P.lq2[lane] * P.lk2[lane] + P.lq2[lane + 64] * P.lk2[lane + 64];
    #pragma unroll
          for (int o = 32; o >= 1; o >>= 1) { a += __shfl_xor(a, o); b += __shfl_xor(b, o); }
          lam = __expf(a) - __expf(b) + 0.2f; }
        if (hi == 0) li_l[r32] = l_reg; asm volatile("s_waitcnt lgkmcnt(0)" ::: "memory");
        LAS unsigned char* reg = lds + wq * 32768;
        if (map == 1) {
#pragma unroll
            for (int r = 0; r < 16; ++r) { const float s = lam * __builtin_amdgcn_rcpf(li_l[crow(r, hi)]);
#pragma unroll
                for (int d = 0; d < 8; ++d) *(LAS float*)(reg + ((d * 16 + r) * 64 + lane) * 4) = o[d][r] * s; }
        }
        MK_BAR();
        if (map == 0) {
#pragma unroll
            for (int r = 0; r < 16; ++r) { const float s = __builtin_amdgcn_rcpf(li_l[crow(r, hi)]);
#pragma unroll
                for (int d = 0; d < 8; ++d) o[d][r] = o[d][r] * s - *(const LAS float*)(reg + ((d * 16 + r) * 64 + lane) * 4); }
            asm volatile("s_waitcnt lgkmcnt(0)" ::: "memory");
#pragma unroll
            for (int r = 0; r < 16; ++r)
#pragma unroll
                for (int d = 0; d < 8; ++d) *(LAS float*)(reg + (crow(r, hi) * 256 + d * 32 + r32) * 4) = o[d][r];
        }
        MK_BAR();
        subln_gate_store(lds, P.da_subln_g, 0.8f, gbuf + qrow0 * 2048 + head * 256, qbuf + qrow0 * 2048 + head * 256, 2048);
        MK_BAR();
    }
}

__device__ __forceinline__ void ret_chain_phase(const Params& P, LAS unsigned char* lds) {
    const int tid = mk_opaque_tid(), wid = __builtin_amdgcn_readfirstlane(tid >> 6), lane = tid & 63, r32 = lane & 31, hi = lane >> 5;
    const int sr = tid >> 4, sc = (tid & 15) * 8, m0 = wid & 3, nb0 = 2 * (wid >> 2);
    const bf16_t* rk = (const bf16_t*)(P.ws + OFF_RK); const bf16_t* rv = (const bf16_t*)(P.ws + OFF_RV);
    const unsigned lds0 = (unsigned)(size_t)lds;
    const unsigned abase = lds0 + (unsigned)v_rd_base(lane) + (unsigned)m0 * 512u, bbase = lds0 + 32768u + (unsigned)v_rd_base(lane) + (unsigned)nb0 * 512u;
    for (int cid = blockIdx.x; cid < GSEQ * 8 * 4; cid += gridDim.x) {
        const int dvh = cid & 1, dir = (cid >> 1) & 1, head = (cid >> 2) & 7, seq = cid >> 5;
        const float lg = -__expf((dir ? P.ret_decay_bwd : P.ret_decay_fwd)[head]) * LOG2E;
        const float cdec = __builtin_amdgcn_exp2f(128.f * lg);
        const bf16_t* kb = rk + (size_t)seq * SEQ * 1024 + head * 128 + sc;
        const bf16_t* vb = rv + (size_t)seq * SEQ * 2048 + head * 256 + dvh * 128 + sc;
        bf16_t* Sbase = (bf16_t*)(P.ws + (dir ? OFF_SB : OFF_SF)) + (size_t)((seq * 8 + head) * 32) * 32768;
        f32x16 acc[2]; acc[0] = f32x16{}; acc[1] = f32x16{};
        bf16x8 kreg[4], vreg[4];
        int c = dir ? 31 : 0;
#pragma unroll
        for (int i = 0; i < 4; ++i) { kreg[i] = *(const bf16x8*)(kb + (size_t)(c * 128 + sr + 32 * i) * 1024); vreg[i] = *(const bf16x8*)(vb + (size_t)(c * 128 + sr + 32 * i) * 2048); }
#define CH_STORE(cc_) do { bf16_t* Sc = Sbase + (size_t)(cc_) * 32768; \
            _Pragma("unroll") for (int nb = 0; nb < 2; ++nb) _Pragma("unroll") for (int q4 = 0; q4 < 4; ++q4) { const int dv = dvh * 128 + 32 * (nb0 + nb) + r32, dk = 32 * m0 + 8 * q4 + 4 * hi; \
                uint2 w; w.x = cvt_pk_bf16(acc[nb][4 * q4 + 0], acc[nb][4 * q4 + 1]); w.y = cvt_pk_bf16(acc[nb][4 * q4 + 2], acc[nb][4 * q4 + 3]); *(uint2*)(Sc + dv * 128 + dk) = w; } } while (0)
        CH_STORE(c);
        for (int s = 0; s < 31; ++s) {
#pragma unroll
            for (int i = 0; i < 4; ++i) { const int j = sr + 32 * i; const float f = __builtin_amdgcn_exp2f(lg * (float)(dir ? j : 127 - j));
                *(LAS bf16x8*)(lds + v_st<4>(j, sc)) = scale8(kreg[i], f); *(LAS bf16x8*)(lds + 32768 + v_st<4>(j, sc)) = vreg[i]; }
            const int cn = dir ? c - 1 : c + 1;
            if (s + 1 < 31) {
#pragma unroll
                for (int i = 0; i < 4; ++i) { kreg[i] = *(const bf16x8*)(kb + (size_t)(cn * 128 + sr + 32 * i) * 1024); vreg[i] = *(const bf16x8*)(vb + (size_t)(cn * 128 + sr + 32 * i) * 2048); } }
            __syncthreads();
#pragma unroll
            for (int r = 0; r < 16; ++r) { acc[0][r] *= cdec; acc[1][r] *= cdec; }
#define CH_STEP(KS) do { const s16x4 al_ = tr_read<(KS) * 4096>(abase), ah_ = tr_read<(KS) * 4096 + 2048>(abase); \
                const s16x4 b0l_ = tr_read<(KS) * 4096>(bbase), b0h_ = tr_read<(KS) * 4096 + 2048>(bbase), b1l_ = tr_read<512 + (KS) * 4096>(bbase), b1h_ = tr_read<512 + (KS) * 4096 + 2048>(bbase); \
                asm volatile("s_waitcnt lgkmcnt(0)" ::: "memory"); SBAR(); \
                acc[0] = __builtin_amdgcn_mfma_f32_32x32x16_bf16(PKLH(al_, ah_), PKLH(b0l_, b0h_), acc[0], 0, 0, 0); \
                acc[1] = __builtin_amdgcn_mfma_f32_32x32x16_bf16(PKLH(al_, ah_), PKLH(b1l_, b1h_), acc[1], 0, 0, 0); } while (0)
            CH_STEP(0); CH_STEP(1); CH_STEP(2); CH_STEP(3); CH_STEP(4); CH_STEP(5); CH_STEP(6); CH_STEP(7);
#undef CH_STEP
            __syncthreads();
            c = cn;
            CH_STORE(c);
        }
#undef CH_STORE
    }
}

template <int D0> __device__ __forceinline__ void ro_pv(f32x16& od, unsigned vb, const bf16x8 (&pa)[8]) {
    const s16x4 l0 = tr_read<D0 * 512 + 0 * 8192>(vb), h0 = tr_read<D0 * 512 + 0 * 8192 + 4096>(vb), l1 = tr_read<D0 * 512 + 1 * 8192>(vb), h1 = tr_read<D0 * 512 + 1 * 8192 + 4096>(vb);
    const s16x4 l2 = tr_read<D0 * 512 + 2 * 8192>(vb), h2 = tr_read<D0 * 512 + 2 * 8192 + 4096>(vb), l3 = tr_read<D0 * 512 + 3 * 8192>(vb), h3 = tr_read<D0 * 512 + 3 * 8192 + 4096>(vb);
    const s16x4 l4 = tr_read<D0 * 512 + 4 * 8192>(vb), h4 = tr_read<D0 * 512 + 4 * 8192 + 4096>(vb), l5 = tr_read<D0 * 512 + 5 * 8192>(vb), h5 = tr_read<D0 * 512 + 5 * 8192 + 4096>(vb);
    const s16x4 l6 = tr_read<D0 * 512 + 6 * 8192>(vb), h6 = tr_read<D0 * 512 + 6 * 8192 + 4096>(vb), l7 = tr_read<D0 * 512 + 7 * 8192>(vb), h7 = tr_read<D0 * 512 + 7 * 8192 + 4096>(vb);
    asm volatile("s_waitcnt lgkmcnt(0)" ::: "memory"); SBAR();
    od = __builtin_amdgcn_mfma_f32_32x32x16_bf16(pa[0], PKLH(l0, h0), od, 0, 0, 0); od = __builtin_amdgcn_mfma_f32_32x32x16_bf16(pa[1], PKLH(l1, h1), od, 0, 0, 0);
    od = __builtin_amdgcn_mfma_f32_32x32x16_bf16(pa[2], PKLH(l2, h2), od, 0, 0, 0); od = __builtin_amdgcn_mfma_f32_32x32x16_bf16(pa[3], PKLH(l3, h3), od, 0, 0, 0);
    od = __builtin_amdgcn_mfma_f32_32x32x16_bf16(pa[4], PKLH(l4, h4), od, 0, 0, 0); od = __builtin_amdgcn_mfma_f32_32x32x16_bf16(pa[5], PKLH(l5, h5), od, 0, 0, 0);
    od = __builtin_amdgcn_mfma_f32_32x32x16_bf16(pa[6], PKLH(l6, h6), od, 0, 0, 0); od = __builtin_amdgcn_mfma_f32_32x32x16_bf16(pa[7], PKLH(l7, h7), od, 0, 0, 0);
}
__device__ __forceinline__ void ret_out_phase(const Params& P, LAS unsigned char* lds) {
    for (int it = blockIdx.x; it < GSEQ * 8 * 32; it += gridDim.x) {
        const int tid = mk_opaque_tid(), wid = __builtin_amdgcn_readfirstlane(tid >> 6), lane = tid & 63, r32 = lane & 31, hi = lane >> 5;
        const int wq = wid & 3, wh = wid >> 2;
        const bf16_t* rq = (const bf16_t*)(P.ws + OFF_RQ); const bf16_t* rk = (const bf16_t*)(P.ws + OFF_RK); bf16_t* rv = (bf16_t*)(P.ws + OFF_RV); const bf16_t* rg = (const bf16_t*)(P.ws + OFF_RG);
        const bf16_t* SF = (const bf16_t*)(P.ws + OFF_SF); const bf16_t* SB = (const bf16_t*)(P.ws + OFF_SB);
        const unsigned lds0 = (unsigned)(size_t)lds;
        LAS unsigned char* bufA = lds; LAS unsigned char* bufB = lds + 65536;
        const int rowL = 4 * wid + (lane >> 4), chL = ((lane & 15) ^ (4 * (wid & 1) + (lane >> 4))) * 8;
        const unsigned kL = (unsigned)(rowL * 1024 + chL) * 2u, sL = (unsigned)(rowL * 128 + chL) * 2u;
        const unsigned vL = (unsigned)((8 * ((lane >> 4) & 1) + 4 * (wid >> 2) + ((lane >> 2) & 3)) * 2048 + (2 * (wid & 3) + (lane >> 5)) * 32 + (lane & 3) * 8) * 2u;
        const int chunk = it & 31, head = (it >> 5) & 7, seq = it >> 8;
        const size_t tokc = (size_t)seq * SEQ + chunk * 128;
        const float lgf = -__expf(P.ret_decay_fwd[head]) * LOG2E, lgb = -__expf(P.ret_decay_bwd[head]) * LOG2E;
        const char* SfT = (const char*)(SF + (size_t)((seq * 8 + head) * 32 + chunk) * 32768); const char* SbT = (const char*)(SB + (size_t)((seq * 8 + head) * 32 + chunk) * 32768);
        const char* kbp = (const char*)(rk + tokc * 1024 + head * 128); const char* vbp = (const char*)(rv + tokc * 2048 + head * 256);
#pragma unroll
        for (int i = 0; i < 4; ++i) __builtin_amdgcn_global_load_lds((const unsigned*)(kbp + (kL + (unsigned)i * (32u * 2048u))), (LAS unsigned*)(bufB + i * 8192 + wid * 1024), 16, 0, 2);
#pragma unroll
        for (int i = 0; i < 8; ++i) __builtin_amdgcn_global_load_lds((const unsigned*)(vbp + (vL + (unsigned)i * (16u * 4096u))), (LAS unsigned*)(bufA + i * 8192 + wid * 1024), 16, 0, 2);
        bf16x8 qr[8];
        { const bf16_t* qp = rq + (tokc + wq * 32 + r32) * 1024 + head * 128 + hi * 8;
#pragma unroll
          for (int d0 = 0; d0 < 8; ++d0) qr[d0] = *(const bf16x8*)(qp + d0 * 16); }
        asm volatile("s_waitcnt vmcnt(0)" ::: "memory"); MK_BAR();
        const int n = 32 * wq + r32;
        bf16x8 pa[8];
#pragma unroll
        for (int kb = 0; kb < 4; ++kb) { f32x16 p = f32x16{};
#pragma unroll
            for (int d0 = 0; d0 < 8; ++d0) { const bf16x8 a = *(const LAS bf16x8*)(bufB + kb * 8192 + KSWZ(r32, (d0 * 16 + hi * 8) * 2)); p = __builtin_amdgcn_mfma_f32_32x32x16_bf16(a, qr[d0], p, 0, 0, 0); }
#pragma unroll
            for (int r = 0; r < 16; ++r) { const int d = n - (32 * kb + crow(r, hi)); const float e = d >= 0 ? (float)d * lgf : (float)(-d) * lgb; p[r] *= __builtin_amdgcn_exp2f(e); }
            PK4(p, 0, pa[2 * kb]); PK4(p, 8, pa[2 * kb + 1]); SBAR(); }
        MK_BAR();
#pragma unroll
        for (int i = 0; i < 8; ++i) __builtin_amdgcn_global_load_lds((const unsigned*)(SfT + (sL + (unsigned)i * 8192u)), (LAS unsigned*)(bufB + i * 8192 + wid * 1024), 16, 0, 2);
        f32x16 o[4];
#pragma unroll
        for (int d = 0; d < 4; ++d) o[d] = f32x16{};
        { const unsigned vb0 = lds0 + (unsigned)v_rd_base(lane) + (unsigned)(4 * wh) * 512u;
          ro_pv<0>(o[0], vb0, pa); ro_pv<1>(o[1], vb0, pa); ro_pv<2>(o[2], vb0, pa); ro_pv<3>(o[3], vb0, pa); }
        MK_BAR();
#pragma unroll
        for (int i = 0; i < 8; ++i) __builtin_amdgcn_global_load_lds((const unsigned*)(SbT + (sL + (unsigned)i * 8192u)), (LAS unsigned*)(bufA + i * 8192 + wid * 1024), 16, 0, 2);
        asm volatile("s_waitcnt vmcnt(8)" ::: "memory"); MK_BAR();
        { const float qs = __builtin_amdgcn_exp2f(lgf * (float)(n + 1));
#pragma unroll
          for (int ks = 0; ks < 8; ++ks) { const bf16x8 qf = scale8(qr[ks], qs);
#pragma unroll
              for (int d0 = 0; d0 < 4; ++d0) { const bf16x8 b = *(const LAS bf16x8*)(bufB + (128 * wh + 32 * d0) * 256 + KSWZ(r32, (16 * ks + 8 * hi) * 2)); o[d0] = __builtin_amdgcn_mfma_f32_32x32x16_bf16(qf, b, o[d0], 0, 0, 0); } } }
        asm volatile("s_waitcnt vmcnt(0)" ::: "memory"); MK_BAR();
        { const float qs = __builtin_amdgcn_exp2f(lgb * (float)(128 - n));
#pragma unroll
          for (int ks = 0; ks < 8; ++ks) { const bf16x8 qf = scale8(qr[ks], qs);
#pragma unroll
              for (int d0 = 0; d0 < 4; ++d0) { const bf16x8 b = *(const LAS bf16x8*)(bufA + (128 * wh + 32 * d0) * 256 + KSWZ(r32, (16 * ks + 8 * hi) * 2)); o[d0] = __builtin_amdgcn_mfma_f32_32x32x16_bf16(qf, b, o[d0], 0, 0, 0); } } }
        MK_BAR();
#pragma unroll
        for (int r = 0; r < 16; ++r)
#pragma unroll
            for (int d = 0; d < 4; ++d) *(LAS float*)(lds + ((32 * wq + crow(r, hi)) * 256 + 128 * wh + 32 * d + r32) * 4) = o[d][r];
        MK_BAR();
        subln_gate_store(lds, P.ret_subln_g, 1.0f, rg + tokc * 2048 + head * 256, rv + tokc * 2048 + head * 256, 2048);
        MK_BAR();
    }
}

__global__ void __launch_bounds__(512) mega(Params P) {
    extern __shared__ __attribute__((aligned(16))) unsigned char shm[];
    LAS unsigned char* lds = (LAS unsigned char*)shm;
    cg::grid_group grid = cg::this_grid();
    volatile LAS unsigned* xst = (volatile LAS unsigned*)(lds + LDS_BYTES - 16);
    if (threadIdx.x == 0) { xst[0] = 0u; xst[1] = 0u; }
    __syncthreads();
    const XcdBarrier xb = xcd_barrier_post((unsigned*)(P.ws + OFF_BAR), xst);
    bf16_t* H = (bf16_t*)(P.ws + OFF_H); bf16_t* big = (bf16_t*)(P.ws + OFF_BIG);
    const bf16_t* WinDA = (const bf16_t*)(P.ws + OFF_WIN_DA); const bf16_t* WoutDA = (const bf16_t*)(P.ws + OFF_WOUT_DA);
    const bf16_t* WinRET = (const bf16_t*)(P.ws + OFF_WIN_RET); const bf16_t* WoutRET = (const bf16_t*)(P.ws + OFF_WOUT_RET);
    const float* tab = (const float*)(P.ws + OFF_TAB);
    prep_phase(P, lds);
    norm_to_bf16(P.x_prompt, P.norm_g, H, MR);
    grid.sync();
    bf16_t* D0 = (bf16_t*)(P.ws + OFF_D0); bf16_t* D1 = (bf16_t*)(P.ws + OFF_D1);
    for (int r = 0; r < NROUND; ++r) {
        const float* xin = r < 2 ? P.x_prompt + (size_t)r * MR * DM : P.x_sample;
        float* xio = P.out + (size_t)r * MR * DM;
        { EpiDA E; E.big = big; E.tcos = tab; E.tsin = tab + 262144; run_gemm(lds, H, WinDA, MR, 8192, 1024, E); }
        if (r > 0) { const float* xp = (r - 1) < 2 ? P.x_prompt + (size_t)(r - 1) * MR * DM : P.x_sample; comb2_norm_out(xp, D0, D1, P.final_norm_g, P.out + (size_t)(r - 1) * MR * DM, MR); }
        xcd_barrier(xb);
        attn_phase(P, lds);
        xcd_barrier(xb);
        { EpiDelta E; E.D = D0; run_gemm(lds, big, WoutDA, MR, 1024, 2048, E); }
        xcd_barrier(xb);
        comb_norm_to_bf16(xin, D0, nullptr, P.norm_g + DM, H, MR);
        xcd_barrier(xb);
        { EpiRET E; E.rq = (bf16_t*)(P.ws + OFF_RQ); E.rk = (bf16_t*)(P.ws + OFF_RK); E.rv = (bf16_t*)(P.ws + OFF_RV); E.rg = (bf16_t*)(P.ws + OFF_RG); E.tcos = tab + 2 * 262144; E.tsin = tab + 3 * 262144;
          run_gemm(lds, H, WinRET, MR, 6144, 1024, E); }
        xcd_barrier(xb);
        ret_chain_phase(P, lds);
        xcd_barrier(xb);
        ret_out_phase(P, lds);
        xcd_barrier(xb);
        { EpiDelta E; E.D = D1; run_gemm(lds, (const bf16_t*)(P.ws + OFF_RV), WoutRET, MR, 1024, 2048, E); }
        if (r + 1 < NROUND) { const float* xn = (r + 1) < 2 ? P.x_prompt + (size_t)(r + 1) * MR * DM : P.x_sample; norm_to_bf16(xn, P.norm_g, H, MR); }
        xcd_barrier(xb);
    }
    comb2_norm_out(P.x_sample, D0, D1, P.final_norm_g, P.out + (size_t)(NROUND - 1) * MR * DM, MR);
}
}

extern "C" void kernel_launch(void* const* d_in, const int* in_sizes, int n_in, void* d_out, int out_size, void* d_ws, size_t ws_size, hipStream_t stream) {
    static int grid_blocks = 0;
    if (!grid_blocks) {
        if (hipFuncSetAttribute((const void*)mk::mega, hipFuncAttributeMaxDynamicSharedMemorySize, (int)mk::LDS_BYTES) != hipSuccess) fprintf(stderr, "kernel_launch: LDS attribute failed\n");
        int dev = 0, cus = 0, per = 0; hipGetDevice(&dev); hipDeviceGetAttribute(&cus, hipDeviceAttributeMultiprocessorCount, dev);
        hipOccupancyMaxActiveBlocksPerMultiprocessor(&per, mk::mega, 512, mk::LDS_BYTES);
        if (per < 1) fprintf(stderr, "kernel_launch: occupancy query says %d blocks/CU\n", per);
        grid_blocks = cus > 0 ? cus : 256;
    }
    mk::Params p{};
    p.x_prompt = (const float*)d_in[0]; p.x_sample = (const float*)d_in[1]; p.norm_g = (const float*)d_in[2]; p.da_w_in = (const float*)d_in[3];
    p.lq1 = (const float*)d_in[4]; p.lk1 = (const float*)d_in[5]; p.lq2 = (const float*)d_in[6]; p.lk2 = (const float*)d_in[7];
    p.da_subln_g = (const float*)d_in[8]; p.da_w_out = (const float*)d_in[9]; p.ret_w_in = (const float*)d_in[10]; p.ret_decay_fwd = (const float*)d_in[11];
    p.ret_decay_bwd = (const float*)d_in[12]; p.ret_subln_g = (const float*)d_in[13]; p.ret_w_out = (const float*)d_in[14]; p.final_norm_g = (const float*)d_in[15];
    p.out = (float*)d_out; p.ws = (unsigned char*)d_ws;
    if (hipMemsetAsync((unsigned char*)d_ws + mk::OFF_BAR, 0, (size_t)XCD_BAR_WORDS * 4, stream) != hipSuccess) fprintf(stderr, "kernel_launch: barrier memset failed\n");
    void* args[] = {&p};
    hipError_t e = hipLaunchCooperativeKernel((void*)mk::mega, dim3(grid_blocks), dim3(512), args, (unsigned)mk::LDS_BYTES, stream);
    if (e != hipSuccess) fprintf(stderr, "kernel_launch: cooperative launch failed: %s (grid %d)\n", hipGetErrorString(e), grid_blocks);
}
```

```cpp
#include <hip/hip_runtime.h>
#include <hip/hip_cooperative_groups.h>
#include <cstdio>
namespace cg = cooperative_groups;
__device__ __forceinline__ int mk_opaque_tid() { int t = threadIdx.x; asm volatile("" : "+v"(t)); return t; }
namespace pg8 {
#define PG8_LAS __attribute__((address_space(3)))
typedef unsigned short bf16_t;
typedef short bf16x8 __attribute__((ext_vector_type(8)));
typedef float f32x4 __attribute__((ext_vector_type(4)));
typedef unsigned u32x4 __attribute__((ext_vector_type(4)));
constexpr int BM = 256, BK = 64, HALF = 128, HTB = HALF * BK * 2  , STAGE_BYTES = 8 * HTB, NXCD = 8, WGM = 8;

__host__ __device__ __forceinline__ int lds_byte(int r, int c) { const int st = (r >> 4) * 2 + (c >> 5), rr = r & 15, cc = c & 31, ob = rr * 64 + cc * 2; return st * 1024 + (ob ^ (((ob >> 9) & 1) << 5)); }
__host__ __device__ __forceinline__ void stage_rc(int b, int& R, int& C) { const int st = b / 1024, sb = b % 1024, swz = sb ^ (((sb >> 9) & 1) << 5); R = (st >> 1) * 16 + swz / 64; C = (st & 1) * 32 + (swz % 64) / 2; }
__host__ __device__ __forceinline__ int perm32(int rho) { const int n = rho >> 4, i = rho & 15; return 8 * (i >> 2) + 4 * n + (i & 3); }

struct Unit { int pm, pn; };
struct Gemm { const bf16_t* A; const bf16_t* Bt; int M, N, K; };

struct StaticOrder {
    int nM, nN, nwg, G, c;
    __host__ __device__ void init(int M, int N, int G_, int c_) { nM = M / BM; nN = N / BM; nwg = nM * nN; G = G_; c = c_; }
    __host__ __device__ bool next(int i, Unit& u) const {
        const long L = (long)i * G + c; if (L >= nwg) return false;
        int wgid = (int)L; { const int q = nwg / NXCD, r = nwg % NXCD, xcd = wgid % NXCD, off = wgid / NXCD; wgid = (xcd < r ? xcd * (q + 1) : r * (q + 1) + (xcd - r) * q) + off; }
        const int nig = WGM * nN, gid = wgid / nig, fm = gid * WGM, gsz = (nM - fm) < WGM ? (nM - fm) : WGM;
        u.pm = fm + ((wgid % nig) % gsz); u.pn = (wgid % nig) / gsz; return true;
    }
    __device__ __forceinline__ void a_ready(const Unit&) const {}
    __device__ __forceinline__ void done(const Unit&) const {}
};
__device__ __forceinline__ unsigned cvt_pk_bf16(float lo, float hi) { unsigned r; asm volatile("v_cvt_pk_bf16_f32 %0, %1, %2" : "=v"(r) : "v"(lo), "v"(hi)); return r; }
template <class Epi, class Sched, bool STAMP = false>
__device__ __forceinline__ void gemm_phase(PG8_LAS unsigned char* lds, const Gemm g, const Sched& S, const Epi& E, unsigned long long* stamps) {
    const int tid = mk_opaque_tid(), wid = __builtin_amdgcn_readfirstlane(tid >> 6), lane = tid & 63, wr = wid >> 2, wc = wid & 3, fr = lane & 15, fq = lane >> 4;
    const int K = g.K, nt = K / BK;
    int ts_lo = 0, ts_hi = 0, nts = 0; const unsigned long long rt_entry = STAMP ? (unsigned long long)wall_clock64() : 0ull;
#define PG8_STAMP() do { if (STAMP && wid == 0 && nts < 64) { const unsigned long long _c = (unsigned long long)clock64(); \
        ts_lo = (lane == nts) ? (int)(unsigned)_c : ts_lo; ts_hi = (lane == nts) ? (int)(unsigned)(_c >> 32) : ts_hi; ++nts; } } while (0)
    PG8_STAMP();
    unsigned voffA[2], voffB[2];
#pragma unroll
    for (int i = 0; i < 2; ++i) { int R, C; stage_rc(tid * 16 + i * 8192, R, C); const int Rb = Epi::PERM ? ((R & ~31) + perm32(R & 31)) : R;
        voffA[i] = (unsigned)(R * K + C) * 2u; voffB[i] = (unsigned)(Rb * K + C) * 2u; }
    const size_t kstep = (size_t)(BK * 2);
    const size_t hstep = (size_t)HALF * K * 2;
    const size_t tstep = 2 * hstep;
    const unsigned ldsw = (unsigned)wid * 1024u;
    const int aoff = lds_byte(wr * 64 + fr, fq * 8), boff = lds_byte(wc * 32 + fr, fq * 8);
#define PG8_SA(b, h) (((b) * 2 + (h)) * HTB)
#define PG8_SB(b, h) ((4 + (b) * 2 + (h)) * HTB)
#define PG8_STAGE(bufoff, gbase, voff) do { _Pragma("unroll") for (int _i = 0; _i < 2; ++_i) \
        __builtin_amdgcn_global_load_lds((const unsigned*)((const char*)(gbase) + (voff)[_i]), (PG8_LAS unsigned*)(lds + (bufoff) + ldsw + _i * 8192), 16, 0, 0); } while (0)
#define PG8_LDA(dst, b, h) do { _Pragma("unroll") for (int m = 0; m < 4; ++m) _Pragma("unroll") for (int k = 0; k < 2; ++k) dst[m][k] = *(const PG8_LAS bf16x8*)(lds + PG8_SA(b, h) + aoff + m * 2048 + k * 1024); } while (0)
#define PG8_LDB(dst, b, h) do { _Pragma("unroll") for (int n = 0; n < 2; ++n) _Pragma("unroll") for (int k = 0; k < 2; ++k) dst[n][k] = *(const PG8_LAS bf16x8*)(lds + PG8_SB(b, h) + boff + n * 2048 + k * 1024); } while (0)
#define PG8_MMA(ai, bj, At, Bt) do { __builtin_amdgcn_s_setprio(1); _Pragma("unroll") for (int m = 0; m < 4; ++m) _Pragma("unroll") for (int n = 0; n < 2; ++n) _Pragma("unroll") for (int k = 0; k < 2; ++k) \
        acc[ai][bj][m][n] = __builtin_amdgcn_mfma_f32_16x16x32_bf16(Bt[n][k], At[m][k], acc[ai][bj][m][n], 0, 0, 0); __builtin_amdgcn_s_setprio(0); } while (0)
#define PG8_WAIT_V(n) asm volatile("s_waitcnt vmcnt(" #n ")" ::: "memory")
#define PG8_WAIT_L(n) asm volatile("s_waitcnt lgkmcnt(" #n ")" ::: "memory")
#define PG8_BAR __builtin_amdgcn_s_barrier()
#define PG8_SCHED __builtin_amdgcn_sched_barrier(0)
    Unit cur, nxt; int ui = 0;
    if (!S.next(0, cur)) return;
    f32x4 acc[2][2][4][2];
#pragma unroll
    for (int a = 0; a < 2; ++a)
#pragma unroll
        for (int b = 0; b < 2; ++b)
#pragma unroll
            for (int m = 0; m < 4; ++m)
#pragma unroll
                for (int n = 0; n < 2; ++n) acc[a][b][m][n] = (f32x4){0.f, 0.f, 0.f, 0.f};
    bf16x8 At[4][2], B0[2][2], B1[2][2];
    const char* cA = (const char*)g.A + (size_t)cur.pm * tstep; const char* cB = (const char*)g.Bt + (size_t)cur.pn * tstep;
    S.a_ready(cur);
    PG8_STAGE(PG8_SB(0, 0), cB, voffB); PG8_STAGE(PG8_SA(0, 0), cA, voffA); PG8_STAGE(PG8_SB(0, 1), cB + hstep, voffB); PG8_STAGE(PG8_SA(0, 1), cA + hstep, voffA);
    if (wr == 1) PG8_BAR;
    PG8_WAIT_V(4); PG8_BAR;
    PG8_STAGE(PG8_SB(1, 0), cB + kstep, voffB); PG8_STAGE(PG8_SA(1, 0), cA + kstep, voffA); PG8_STAGE(PG8_SB(1, 1), cB + hstep + kstep, voffB);
    PG8_WAIT_V(6); PG8_BAR;
    PG8_STAMP();
    for (;;) {
        const bool has_next = S.next(ui + 1, nxt);
        const char* nA = has_next ? (const char*)g.A + (size_t)nxt.pm * tstep : cA; const char* nB = has_next ? (const char*)g.Bt + (size_t)nxt.pn * tstep : cB;
        for (int t = 0; t < nt; t += 2) {
            const bool last = (t == nt - 2);
            const char* a1 = cA + (size_t)(t + 1) * kstep;
            const char* a2 = last ? nA : cA + (size_t)(t + 2) * kstep; const char* b2 = last ? nB : cB + (size_t)(t + 2) * kstep;
            const char* a3 = a2 + kstep; const char* b3 = b2 + kstep;
            if (last && has_next) S.a_ready(nxt);
            PG8_LDB(B0, 0, 0); PG8_SCHED; PG8_LDA(At, 0, 0); PG8_STAGE(PG8_SA(1, 1), a1 + hstep, voffA);
            PG8_WAIT_L(8); PG8_BAR; PG8_WAIT_L(0); PG8_MMA(0, 0, At, B0); PG8_BAR; PG8_SCHED;
            PG8_LDB(B1, 0, 1); PG8_STAGE(PG8_SB(0, 0), b2, voffB);
            PG8_BAR; PG8_WAIT_L(0); PG8_MMA(0, 1, At, B1); PG8_BAR;
            PG8_LDA(At, 0, 1); PG8_STAGE(PG8_SA(0, 0), a2, voffA);
            PG8_BAR; PG8_WAIT_L(0); PG8_MMA(1, 0, At, B0); PG8_BAR; PG8_SCHED;
            PG8_STAGE(PG8_SB(0, 1), b2 + hstep, voffB);
            PG8_WAIT_V(6); PG8_BAR; PG8_MMA(1, 1, At, B1); PG8_BAR;
            PG8_LDB(B0, 1, 0); PG8_SCHED; PG8_LDA(At, 1, 0); PG8_STAGE(PG8_SA(0, 1), a2 + hstep, voffA);
            PG8_WAIT_L(8); PG8_BAR; PG8_WAIT_L(0); PG8_MMA(0, 0, At, B0); PG8_BAR; PG8_SCHED;
            PG8_LDB(B1, 1, 1); PG8_STAGE(PG8_SB(1, 0), b3, voffB);
            PG8_BAR; PG8_WAIT_L(0); PG8_MMA(0, 1, At, B1); PG8_BAR;
            PG8_LDA(At, 1, 1); PG8_STAGE(PG8_SA(1, 0), a3, voffA);
            PG8_BAR; PG8_WAIT_L(0); PG8_MMA(1, 0, At, B0); PG8_BAR; PG8_SCHED;
            PG8_STAGE(PG8_SB(1, 1), b3 + hstep, voffB);
            PG8_WAIT_V(6); PG8_BAR; PG8_MMA(1, 1, At, B1); PG8_BAR;
        }
        PG8_STAMP();
        if constexpr (!Epi::AFTER_DRAIN) { E(acc, cur, wr, wc, fr, fq); S.done(cur); }
        PG8_STAMP();
        if (!has_next) break;
#pragma unroll
        for (int a = 0; a < 2; ++a)
#pragma unroll
            for (int b = 0; b < 2; ++b)
#pragma unroll
                for (int m = 0; m < 4; ++m)
#pragma unroll
                    for (int n = 0; n < 2; ++n) acc[a][b][m][n] = (f32x4){0.f, 0.f, 0.f, 0.f};
        cur = nxt; cA = nA; cB = nB; ++ui;
    }
    PG8_WAIT_V(0);
    if (wr == 0) PG8_BAR;
    PG8_BAR;
    if constexpr (Epi::AFTER_DRAIN) { E.fused(acc, cur, wr, wc, fr, fq, lds, wid, lane); S.done(cur); }
    PG8_STAMP();
    if (STAMP && wid == 0) { stamps[lane] = lane < nts ? (((unsigned long long)(unsigned)ts_hi << 32) | (unsigned)ts_lo) : 0ull;
        if (lane == 62) stamps[62] = rt_entry; if (lane == 63) stamps[63] = (unsigned long long)wall_clock64(); }
#undef PG8_STAMP
#undef PG8_SA
#undef PG8_SB
#undef PG8_STAGE
#undef PG8_LDA
#undef PG8_LDB
#undef PG8_MMA
#undef PG8_WAIT_V
#undef PG8_WAIT_L
#undef PG8_BAR
#undef PG8_SCHED
}
}

namespace mk {
using pg8::bf16_t; using pg8::bf16x8; using pg8::f32x4; using pg8::u32x4; using pg8::Unit; using pg8::Gemm; using pg8::StaticOrder; using pg8::cvt_pk_bf16;
typedef short s16x4 __attribute__((ext_vector_type(4)));
typedef float f32x16 __attribute__((ext_vector_type(16)));
#define LAS __attribute__((address_space(3)))

#define XB_TMO      128
#define XB_XCNT(j)  (256  + 64 * (j))
#define XB_XSUB(j)  (1280 + 64 * (j))
#define XB_XGEN(j)  (2304 + 64 * (j))
#define XB_TOP      3328
#define XB_TOPGEN   3392
#define XCD_BAR_WORDS 3456
#define XB_SPIN_CAP (1u << 18)

__device__ __forceinline__ unsigned xb_ld(unsigned* p)              { return __hip_atomic_load(p, __ATOMIC_RELAXED, __HIP_MEMORY_SCOPE_AGENT); }
__device__ __forceinline__ unsigned xb_add(unsigned* p, unsigned v) { return __hip_atomic_fetch_add(p, v, __ATOMIC_RELAXED, __HIP_MEMORY_SCOPE_AGENT); }
__device__ __forceinline__ unsigned xb_xcc_id() { return (unsigned)__builtin_amdgcn_s_getreg((3 << 11) | 20) & 0xFu; }
#define XB_SPIN(cond, bar) do { unsigned _sp = 0; while (cond) { __builtin_amdgcn_s_sleep(1); \
    if ((++_sp & 255u) == 0u) { if (xb_ld(&(bar)[XB_TMO])) break; if (_sp > XB_SPIN_CAP) { atomicAdd(&(bar)[XB_TMO], 1u); break; } } } } while (0)

struct XcdBarrier {
    unsigned* bar; unsigned x;
    volatile LAS unsigned* st;
};

__device__ __forceinline__ XcdBarrier xcd_barrier_post(unsigned* bar, volatile LAS unsigned* st) {
    XcdBarrier b; b.bar = bar; b.x = xb_xcc_id(); b.st = st;
    if (threadIdx.x == 0) (void)xb_add(&bar[XB_XCNT(b.x)], 1u);
    return b;
}
__device__ __forceinline__ void xcd_barrier_complete(unsigned* bar, unsigned x, unsigned& nloc, unsigned& nx) {
    const unsigned G = gridDim.x * gridDim.y * gridDim.z;
    unsigned sum, cnt, mine, sp = 0u;
    for (;;) {
        sum = 0u; cnt = 0u; mine = 0u;
#pragma unroll
        for (unsigned j = 0; j < 16; ++j) { const unsigned c = xb_ld(&bar[XB_XCNT(j)]); sum += c; cnt += (c > 0u) ? 1u : 0u; mine = (j == x) ? c : mine; }
        if (sum == G) break;
        __builtin_amdgcn_s_sleep(1);
        if ((++sp & 255u) == 0u) { if (xb_ld(&bar[XB_TMO])) break; if (sp > XB_SPIN_CAP) { atomicAdd(&bar[XB_TMO], 1u); break; } }
    }
    nloc = mine > 0u ? mine : 1u; nx = cnt > 0u ? cnt : 1u;
}

__device__ __forceinline__ void xcd_barrier(const XcdBarrier& b) {
    asm volatile("s_waitcnt vmcnt(0)" ::: "memory");
    __syncthreads();
    if (threadIdx.x == 0) {
        unsigned* bar = b.bar;
        __builtin_amdgcn_s_waitcnt(0);
        unsigned nloc = b.st[0], nx = b.st[1];
        if (nloc == 0u) { xcd_barrier_complete(bar, b.x, nloc, nx); b.st[0] = nloc; b.st[1] = nx; }
        const unsigned old = xb_add(&bar[XB_XSUB(b.x)], 1u);
        const unsigned gen = old / nloc;
        if (old + 1u == (gen + 1u) * nloc) {
            __builtin_amdgcn_fence(__ATOMIC_RELEASE, "agent");
            asm volatile("s_waitcnt vmcnt(0)" ::: "memory");
            const unsigned og = xb_add(&bar[XB_TOP], 1u);
            const unsigned tg = og / nx;
            if (og + 1u == (tg + 1u) * nx) xb_add(&bar[XB_TOPGEN], 1u);
            else XB_SPIN(xb_ld(&bar[XB_TOPGEN]) == tg, bar);
            __builtin_amdgcn_fence(__ATOMIC_ACQUIRE, "agent");
            xb_add(&bar[XB_XGEN(b.x)], 1u);
            asm volatile("s_waitcnt vmcnt(0)" ::: "memory");
        } else {
            XB_SPIN(xb_ld(&bar[XB_XGEN(b.x)]) == gen, bar);
            __builtin_amdgcn_fence(__ATOMIC_ACQUIRE, "agent");
            asm volatile("s_waitcnt vmcnt(0)" ::: "memory");
        }
    }
    __syncthreads();
}


constexpr int SEQ = 4096, DM = 1024, DI = 2048, GSEQ = 8, MR = GSEQ * SEQ, NROUND = 3;
constexpr size_t LDS_BYTES = 136 * 1024;
constexpr size_t OFF_WIN_DA = 0, OFF_WOUT_DA = OFF_WIN_DA + (size_t)8192 * 1024 * 2, OFF_WIN_RET = OFF_WOUT_DA + (size_t)1024 * 2048 * 2,
                 OFF_WOUT_RET = OFF_WIN_RET + (size_t)6144 * 1024 * 2, OFF_TAB = OFF_WOUT_RET + (size_t)1024 * 2048 * 2,
                 OFF_H = OFF_TAB + (size_t)4 * 4096 * 64 * 4, OFF_BIG = OFF_H + (size_t)MR * DM * 2;
constexpr size_t SZ_2048 = (size_t)MR * 2048 * 2, SZ_1024 = (size_t)MR * 1024 * 2;
constexpr size_t OFF_D0 = OFF_BIG + (size_t)5 * ((size_t)MR * 2048 * 2) + 1048576, OFF_D1 = OFF_D0 + (size_t)3 * MR * DM * 2, OFF_BAR = OFF_D1 + (size_t)MR * DM * 2;
constexpr size_t OFF_RQ = OFF_BIG, OFF_RK = OFF_RQ + SZ_1024, OFF_RV = OFF_RK + SZ_1024, OFF_RG = OFF_RV + SZ_2048, OFF_SF = OFF_RG + SZ_2048, OFF_SB = OFF_SF + SZ_2048;

struct Params {
    const float* x_prompt; const float* x_sample; const float* norm_g; const float* da_w_in; const float* lq1; const float* lk1; const float* lq2; const float* lk2;
    const float* da_subln_g; const float* da_w_out; const float* ret_w_in; const float* ret_decay_fwd; const float* ret_decay_bwd; const float* ret_subln_g;
    const float* ret_w_out; const float* final_norm_g; float* out; unsigned char* ws;
};

__device__ __forceinline__ unsigned short f2bf(float f) { unsigned u = __float_as_uint(f); u += 0x7FFFu + ((u >> 16) & 1u); return (unsigned short)(u >> 16); }
__device__ __forceinline__ float bflo(unsigned w) { return __uint_as_float(w << 16); }
__device__ __forceinline__ float bfhi(unsigned w) { return __uint_as_float(w & 0xffff0000u); }
__device__ __forceinline__ bf16x8 scale8(bf16x8 x, float f) {
    u32x4 w = *reinterpret_cast<u32x4*>(&x); u32x4 r;
    r.x = cvt_pk_bf16(bflo(w.x) * f, bfhi(w.x) * f); r.y = cvt_pk_bf16(bflo(w.y) * f, bfhi(w.y) * f);
    r.z = cvt_pk_bf16(bflo(w.z) * f, bfhi(w.z) * f); r.w = cvt_pk_bf16(bflo(w.w) * f, bfhi(w.w) * f);
    return *reinterpret_cast<bf16x8*>(&r);
}
#define MK_BAR() do { asm volatile("" ::: "memory"); __builtin_amdgcn_s_barrier(); asm volatile("" ::: "memory"); } while (0)
#define SBAR() __builtin_amdgcn_sched_barrier(0)
#define KSWZ(row, colB) ((row) * 256 + ((colB) ^ (((row) & 7) << 4)))
__device__ __forceinline__ int crow(int r, int hi) { return (r & 3) + 8 * (r >> 2) + 4 * hi; }
template <int NCG> __device__ __forceinline__ int v_st(int k, int c) { const int kk = (k & ~0xC) | ((k & 4) << 1) | ((k & 8) >> 1); return ((kk >> 3) * NCG + (c >> 5)) * 512 + ((kk & 7) * 32 + (c & 31)) * 2; }
__device__ __forceinline__ int v_rd_base(int lane) { return ((lane & 3) << 3) | (((lane >> 2) & 3) << 6) | (((lane >> 4) & 1) << 5) | (((lane >> 5) & 1) << 8); }
template <int OFF> __device__ __forceinline__ s16x4 tr_read(unsigned vb) {
    s16x4 r; asm volatile("ds_read_b64_tr_b16 %0, %1 offset:%2" : "=&v"(r) : "v"(vb), "i"(OFF) : "memory"); return r;
}
#define PKLH(L, H) (bf16x8){L[0], L[1], L[2], L[3], H[0], H[1], H[2], H[3]}
#define PK4(P, BASE, OUT) do { unsigned a0 = cvt_pk_bf16(P[BASE + 0], P[BASE + 1]), a1 = cvt_pk_bf16(P[BASE + 2], P[BASE + 3]);   \
    unsigned b0 = cvt_pk_bf16(P[BASE + 4], P[BASE + 5]), b1 = cvt_pk_bf16(P[BASE + 6], P[BASE + 7]);                              \
    auto r0 = __builtin_amdgcn_permlane32_swap(a0, b0, false, false); auto r1 = __builtin_amdgcn_permlane32_swap(a1, b1, false, false); \
    u32x4 w_ = {r0[0], r1[0], r0[1], r1[1]}; OUT = *reinterpret_cast<bf16x8*>(&w_); } while (0)

__device__ __forceinline__ void transpose_tile(const float* __restrict__ W, bf16_t* __restrict__ Wt, int K, int N, bool permDA, int tile, LAS float* t) {
    const int ntn = N / 64, kt = tile / ntn, nt = tile % ntn, k0 = kt * 64, n0 = nt * 64, tid = mk_opaque_tid();
#pragma unroll
    for (int i = 0; i < 8; ++i) { const int k = i * 8 + (tid >> 6), n = tid & 63; t[k * 65 + n] = W[(size_t)(k0 + k) * N + n0 + n]; }
    __syncthreads();
#pragma unroll
    for (int i = 0; i < 8; ++i) { const int n = i * 8 + (tid >> 6), k = tid & 63; const int ns = n0 + n; int nd = ns;
        if (permDA && ns < 4096) { const int d = ns & 127; nd = (ns & ~127) + (d < 64 ? 2 * d : 2 * (d - 64) + 1); }
        Wt[(size_t)nd * K + k0 + k] = f2bf(t[k * 65 + n]); }
    __syncthreads();
}
__device__ __forceinline__ void prep_phase(const Params& P, LAS unsigned char* lds) {
    LAS float* t = (LAS float*)lds;
    bf16_t* w0 = (bf16_t*)(P.ws + OFF_WIN_DA); bf16_t* w1 = (bf16_t*)(P.ws + OFF_WOUT_DA); bf16_t* w2 = (bf16_t*)(P.ws + OFF_WIN_RET); bf16_t* w3 = (bf16_t*)(P.ws + OFF_WOUT_RET);
    constexpr int T0 = 16 * 128, T1 = 32 * 16, T2 = 16 * 96, T3 = 32 * 16;
    for (int i = blockIdx.x; i < T0 + T1 + T2 + T3; i += gridDim.x) {
        if (i < T0) transpose_tile(P.da_w_in, w0, 1024, 8192, true, i, t);
        else if (i < T0 + T1) transpose_tile(P.da_w_out, w1, 2048, 1024, false, i - T0, t);
        else if (i < T0 + T1 + T2) transpose_tile(P.ret_w_in, w2, 1024, 6144, false, i - T0 - T1, t);
        else transpose_tile(P.ret_w_out, w3, 2048, 1024, false, i - T0 - T1 - T2, t);
    }
    float* tab = (float*)(P.ws + OFF_TAB);
    for (int idx = blockIdx.x * 512 + threadIdx.x; idx < 2 * 4096 * 64; idx += gridDim.x * 512) {
        const int which = idx >> 18, e = idx & 262143, pos = e >> 6, i = e & 63;
        const double ex = which ? (double)i / 63.0 : (double)i / 64.0;
        const float inv = (float)exp(-ex * 9.210340371976184);
        const float ang = (float)pos * inv;
        double rev = (double)ang * 0.15915494309189535; rev -= rint(rev);
        const float rr = (float)(rev * 6.283185307179586);
        tab[(size_t)(which * 2) * 262144 + e] = __cosf(rr); tab[(size_t)(which * 2 + 1) * 262144 + e] = __sinf(rr);
    }
}

__device__ __forceinline__ void norm_to_bf16(const float* __restrict__ X, const float* __restrict__ g, bf16_t* __restrict__ H, int rows) {
    const int tid_ = mk_opaque_tid(), lane = tid_ & 63, gw = blockIdx.x * 8 + (tid_ >> 6), nw = gridDim.x * 8;
    f32x4 gv[4];
#pragma unroll
    for (int j = 0; j < 4; ++j) gv[j] = *(const f32x4*)(g + j * 256 + lane * 4);
    for (int r0 = gw; r0 < rows; r0 += 4 * nw) {
        f32x4 v[4][4];
#pragma unroll
        for (int q = 0; q < 4; ++q)
#pragma unroll
            for (int j = 0; j < 4; ++j) v[q][j] = __builtin_nontemporal_load((const f32x4*)(X + (size_t)(r0 + q * nw) * DM + j * 256 + lane * 4));
#pragma unroll
        for (int q = 0; q < 4; ++q) { float ss = 0.f;
#pragma unroll
            for (int j = 0; j < 4; ++j) ss += v[q][j][0] * v[q][j][0] + v[q][j][1] * v[q][j][1] + v[q][j][2] * v[q][j][2] + v[q][j][3] * v[q][j][3];
#pragma unroll
            for (int o = 32; o >= 1; o >>= 1) ss += __shfl_xor(ss, o);
            const float rs = rsqrtf(ss * (1.0f / DM) + 1e-6f);
#pragma unroll
            for (int j = 0; j < 4; ++j) { uint2 w; w.x = cvt_pk_bf16(v[q][j][0] * rs * gv[j][0], v[q][j][1] * rs * gv[j][1]); w.y = cvt_pk_bf16(v[q][j][2] * rs * gv[j][2], v[q][j][3] * rs * gv[j][3]);
                *(uint2*)(H + (size_t)(r0 + q * nw) * DM + j * 256 + lane * 4) = w; } }
    }
}
__device__ __forceinline__ void norm_inplace_f32(float* __restrict__ X, const float* __restrict__ g, int rows) {
    const int tid_ = mk_opaque_tid(), lane = tid_ & 63, gw = blockIdx.x * 8 + (tid_ >> 6), nw = gridDim.x * 8;
    f32x4 gv[4];
#pragma unroll
    for (int j = 0; j < 4; ++j) gv[j] = *(const f32x4*)(g + j * 256 + lane * 4);
    for (int r0 = gw; r0 < rows; r0 += 4 * nw) {
        f32x4 v[4][4];
#pragma unroll
        for (int q = 0; q < 4; ++q)
#pragma unroll
            for (int j = 0; j < 4; ++j) v[q][j] = *(const f32x4*)(X + (size_t)(r0 + q * nw) * DM + j * 256 + lane * 4);
#pragma unroll
        for (int q = 0; q < 4; ++q) { float ss = 0.f;
#pragma unroll
            for (int j = 0; j < 4; ++j) ss += v[q][j][0] * v[q][j][0] + v[q][j][1] * v[q][j][1] + v[q][j][2] * v[q][j][2] + v[q][j][3] * v[q][j][3];
#pragma unroll
            for (int o = 32; o >= 1; o >>= 1) ss += __shfl_xor(ss, o);
            const float rs = rsqrtf(ss * (1.0f / DM) + 1e-6f);
#pragma unroll
            for (int j = 0; j < 4; ++j) { f32x4 y = {v[q][j][0] * rs * gv[j][0], v[q][j][1] * rs * gv[j][1], v[q][j][2] * rs * gv[j][2], v[q][j][3] * rs * gv[j][3]}; *(f32x4*)(X + (size_t)(r0 + q * nw) * DM + j * 256 + lane * 4) = y; } }
    }
}

__device__ __forceinline__ void comb_norm_to_bf16(const float* __restrict__ Xin, const bf16_t* __restrict__ D, float* __restrict__ Xout, const float* __restrict__ g, bf16_t* __restrict__ H, int rows) {
    const int tid_ = mk_opaque_tid(), lane = tid_ & 63, gw = blockIdx.x * 8 + (tid_ >> 6), nw = gridDim.x * 8;
    f32x4 gv[4];
#pragma unroll
    for (int j = 0; j < 4; ++j) gv[j] = *(const f32x4*)(g + j * 256 + lane * 4);
    for (int r0 = gw; r0 < rows; r0 += 4 * nw) {
        f32x4 v[4][4]; uint2 d[4][4];
#pragma unroll
        for (int q = 0; q < 4; ++q)
#pragma unroll
            for (int j = 0; j < 4; ++j) { const size_t o = (size_t)(r0 + q * nw) * DM + j * 256 + lane * 4; v[q][j] = *(const f32x4*)(Xin + o); d[q][j] = *(const uint2*)(D + o); }
#pragma unroll
        for (int q = 0; q < 4; ++q) { float ss = 0.f;
#pragma unroll
            for (int j = 0; j < 4; ++j) { v[q][j][0] += bflo(d[q][j].x); v[q][j][1] += bfhi(d[q][j].x); v[q][j][2] += bflo(d[q][j].y); v[q][j][3] += bfhi(d[q][j].y);
                ss += v[q][j][0] * v[q][j][0] + v[q][j][1] * v[q][j][1] + v[q][j][2] * v[q][j][2] + v[q][j][3] * v[q][j][3]; }
#pragma unroll
            for (int o = 32; o >= 1; o >>= 1) ss += __shfl_xor(ss, o);
            const float rs = rsqrtf(ss * (1.0f / DM) + 1e-6f);
#pragma unroll
            for (int j = 0; j < 4; ++j) { const size_t o = (size_t)(r0 + q * nw) * DM + j * 256 + lane * 4; if (Xout) *(f32x4*)(Xout + o) = v[q][j];
                uint2 w; w.x = cvt_pk_bf16(v[q][j][0] * rs * gv[j][0], v[q][j][1] * rs * gv[j][1]); w.y = cvt_pk_bf16(v[q][j][2] * rs * gv[j][2], v[q][j][3] * rs * gv[j][3]);
                *(uint2*)(H + o) = w; } }
    }
}
__device__ __forceinline__ void comb_norm_inplace_f32(float* __restrict__ X, const bf16_t* __restrict__ D, const float* __restrict__ g, int rows) {
    const int tid_ = mk_opaque_tid(), lane = tid_ & 63, gw = blockIdx.x * 8 + (tid_ >> 6), nw = gridDim.x * 8;
    f32x4 gv[4];
#pragma unroll
    for (int j = 0; j < 4; ++j) gv[j] = *(const f32x4*)(g + j * 256 + lane * 4);
    for (int r0 = gw; r0 < rows; r0 += 4 * nw) {
        f32x4 v[4][4]; uint2 d[4][4];
#pragma unroll
        for (int q = 0; q < 4; ++q)
#pragma unroll
            for (int j = 0; j < 4; ++j) { const size_t o = (size_t)(r0 + q * nw) * DM + j * 256 + lane * 4; v[q][j] = *(const f32x4*)(X + o); d[q][j] = *(const uint2*)(D + o); }
#pragma unroll
        for (int q = 0; q < 4; ++q) { float ss = 0.f;
#pragma unroll
            for (int j = 0; j < 4; ++j) { v[q][j][0] += bflo(d[q][j].x); v[q][j][1] += bfhi(d[q][j].x); v[q][j][2] += bflo(d[q][j].y); v[q][j][3] += bfhi(d[q][j].y);
                ss += v[q][j][0] * v[q][j][0] + v[q][j][1] * v[q][j][1] + v[q][j][2] * v[q][j][2] + v[q][j][3] * v[q][j][3]; }
#pragma unroll
            for (int o = 32; o >= 1; o >>= 1) ss += __shfl_xor(ss, o);
            const float rs = rsqrtf(ss * (1.0f / DM) + 1e-6f);
#pragma unroll
            for (int j = 0; j < 4; ++j) { f32x4 y = {v[q][j][0] * rs * gv[j][0], v[q][j][1] * rs * gv[j][1], v[q][j][2] * rs * gv[j][2], v[q][j][3] * rs * gv[j][3]}; *(f32x4*)(X + (size_t)(r0 + q * nw) * DM + j * 256 + lane * 4) = y; } }
    }
}

__device__ __forceinline__ void comb2_norm_out(const float* __restrict__ Xin, const bf16_t* __restrict__ Da, const bf16_t* __restrict__ Db, const float* __restrict__ g, float* __restrict__ Out, int rows) {
    const int tid_ = mk_opaque_tid(), lane = tid_ & 63, gw = blockIdx.x * 8 + (tid_ >> 6), nw = gridDim.x * 8;
    f32x4 gv[4];
#pragma unroll
    for (int j = 0; j < 4; ++j) gv[j] = *(const f32x4*)(g + j * 256 + lane * 4);
    for (int r0 = gw; r0 < rows; r0 += 4 * nw) {
        f32x4 v[4][4]; uint2 da[4][4], db[4][4];
#pragma unroll
        for (int q = 0; q < 4; ++q)
#pragma unroll
            for (int j = 0; j < 4; ++j) { const size_t o = (size_t)(r0 + q * nw) * DM + j * 256 + lane * 4; v[q][j] = __builtin_nontemporal_load((const f32x4*)(Xin + o)); { typedef unsigned u32x2v_ __attribute__((ext_vector_type(2))); const u32x2v_ ta = __builtin_nontemporal_load((const u32x2v_*)(Da + o)), tb = __builtin_nontemporal_load((const u32x2v_*)(Db + o)); da[q][j].x = ta[0]; da[q][j].y = ta[1]; db[q][j].x = tb[0]; db[q][j].y = tb[1]; } }
#pragma unroll
        for (int q = 0; q < 4; ++q) { float ss = 0.f;
#pragma unroll
            for (int j = 0; j < 4; ++j) { v[q][j][0] += bflo(da[q][j].x) + bflo(db[q][j].x); v[q][j][1] += bfhi(da[q][j].x) + bfhi(db[q][j].x); v[q][j][2] += bflo(da[q][j].y) + bflo(db[q][j].y); v[q][j][3] += bfhi(da[q][j].y) + bfhi(db[q][j].y);
                ss += v[q][j][0] * v[q][j][0] + v[q][j][1] * v[q][j][1] + v[q][j][2] * v[q][j][2] + v[q][j][3] * v[q][j][3]; }
#pragma unroll
            for (int o = 32; o >= 1; o >>= 1) ss += __shfl_xor(ss, o);
            const float rs = rsqrtf(ss * (1.0f / DM) + 1e-6f);
#pragma unroll
            for (int j = 0; j < 4; ++j) { f32x4 y = {v[q][j][0] * rs * gv[j][0], v[q][j][1] * rs * gv[j][1], v[q][j][2] * rs * gv[j][2], v[q][j][3] * rs * gv[j][3]}; __builtin_nontemporal_store(y, (f32x4*)(Out + (size_t)(r0 + q * nw) * DM + j * 256 + lane * 4)); } }
    }
}

__device__ __forceinline__ u32x4 rot_pack(f32x4 v0, f32x4 v1, const float* tc, const float* ts, float sc) {
    const f32x4 c = *(const f32x4*)tc, s = *(const f32x4*)ts; u32x4 w;
    w.x = cvt_pk_bf16((v0[0] * c[0] - v0[1] * s[0]) * sc, (v0[1] * c[0] + v0[0] * s[0]) * sc);
    w.y = cvt_pk_bf16((v0[2] * c[1] - v0[3] * s[1]) * sc, (v0[3] * c[1] + v0[2] * s[1]) * sc);
    w.z = cvt_pk_bf16((v1[0] * c[2] - v1[1] * s[2]) * sc, (v1[1] * c[2] + v1[0] * s[2]) * sc);
    w.w = cvt_pk_bf16((v1[2] * c[3] - v1[3] * s[3]) * sc, (v1[3] * c[3] + v1[2] * s[3]) * sc);
    return w;
}
__device__ __forceinline__ u32x4 plain_pack(f32x4 v0, f32x4 v1) { u32x4 w; w.x = cvt_pk_bf16(v0[0], v0[1]); w.y = cvt_pk_bf16(v0[2], v0[3]); w.z = cvt_pk_bf16(v1[0], v1[1]); w.w = cvt_pk_bf16(v1[2], v1[3]); return w; }

struct EpiDA {
    static constexpr bool PERM = true, AFTER_DRAIN = false;
    bf16_t* big; const float* tcos; const float* tsin;
    __device__ __forceinline__ void operator()(const f32x4 (&acc)[2][2][4][2], const Unit& u, int wr, int wc, int fr, int fq) const {
        const int region = u.pn >> 3; bf16_t* base = big + (size_t)region * ((size_t)MR * 2048);
        const int colr0 = (u.pn & 7) * 256 + wc * 32 + 8 * fq, row0 = u.pm * 256 + wr * 64 + fr;
        if (region < 2) {
            const int i0 = (colr0 & 127) >> 1; const float sc = region == 0 ? 0.08838834764831845f : 1.0f;
            f32x4 cs[8], sn[8];
#pragma unroll
            for (int q = 0; q < 8; ++q) { const int pos = (row0 + (q >> 2) * 128 + (q & 3) * 16) & (SEQ - 1); cs[q] = *(const f32x4*)(tcos + pos * 64 + i0); sn[q] = *(const f32x4*)(tsin + pos * 64 + i0); }
            asm volatile("" ::: "memory");
#pragma unroll
            for (int q = 0; q < 8; ++q) { const int ai = q >> 2, m = q & 3, row = row0 + ai * 128 + m * 16; const f32x4 c = cs[q], s = sn[q];
#pragma unroll
                for (int bj = 0; bj < 2; ++bj) { const f32x4 v0 = acc[ai][bj][m][0], v1 = acc[ai][bj][m][1]; u32x4 w;
                    w.x = cvt_pk_bf16((v0[0] * c[0] - v0[1] * s[0]) * sc, (v0[1] * c[0] + v0[0] * s[0]) * sc);
                    w.y = cvt_pk_bf16((v0[2] * c[1] - v0[3] * s[1]) * sc, (v0[3] * c[1] + v0[2] * s[1]) * sc);
                    w.z = cvt_pk_bf16((v1[0] * c[2] - v1[1] * s[2]) * sc, (v1[1] * c[2] + v1[0] * s[2]) * sc);
                    w.w = cvt_pk_bf16((v1[2] * c[3] - v1[3] * s[3]) * sc, (v1[3] * c[3] + v1[2] * s[3]) * sc);
                    *(u32x4*)(base + (size_t)row * 2048 + colr0 + bj * 128) = w; } }
        } else {
#pragma unroll
            for (int ai = 0; ai < 2; ++ai)
#pragma unroll
                for (int m = 0; m < 4; ++m) { const int row = row0 + ai * 128 + m * 16;
#pragma unroll
                    for (int bj = 0; bj < 2; ++bj) *(u32x4*)(base + (size_t)row * 2048 + colr0 + bj * 128) = plain_pack(acc[ai][bj][m][0], acc[ai][bj][m][1]); }
        }
    }
};
struct EpiRET {
    static constexpr bool PERM = true, AFTER_DRAIN = false;
    bf16_t* rq; bf16_t* rk; bf16_t* rv; bf16_t* rg; const float* tcos; const float* tsin;
    __device__ __forceinline__ void operator()(const f32x4 (&acc)[2][2][4][2], const Unit& u, int wr, int wc, int fr, int fq) const {
        const bool isrot = u.pn < 8; bf16_t* base; int ld, colt;
        if (u.pn < 4) { base = rq; ld = 1024; colt = u.pn * 256; } else if (u.pn < 8) { base = rk; ld = 1024; colt = (u.pn - 4) * 256; }
        else if (u.pn < 16) { base = rv; ld = 2048; colt = (u.pn - 8) * 256; } else { base = rg; ld = 2048; colt = (u.pn - 16) * 256; }
        const int colr0 = colt + wc * 32 + 8 * fq, row0 = u.pm * 256 + wr * 64 + fr;
        if (isrot) {
            const int i0 = (colr0 & 127) >> 1; const float sc = u.pn >= 4 ? 0.08838834764831845f : 1.0f;
            f32x4 cs[8], sn[8];
#pragma unroll
            for (int q = 0; q < 8; ++q) { const int pos = (row0 + (q >> 2) * 128 + (q & 3) * 16) & (SEQ - 1); cs[q] = *(const f32x4*)(tcos + pos * 64 + i0); sn[q] = *(const f32x4*)(tsin + pos * 64 + i0); }
            asm volatile("" ::: "memory");
#pragma unroll
            for (int q = 0; q < 8; ++q) { const int ai = q >> 2, m = q & 3, row = row0 + ai * 128 + m * 16; const f32x4 c = cs[q], s = sn[q];
#pragma unroll
                for (int bj = 0; bj < 2; ++bj) { const f32x4 v0 = acc[ai][bj][m][0], v1 = acc[ai][bj][m][1]; u32x4 w;
                    w.x = cvt_pk_bf16((v0[0] * c[0] - v0[1] * s[0]) * sc, (v0[1] * c[0] + v0[0] * s[0]) * sc);
                    w.y = cvt_pk_bf16((v0[2] * c[1] - v0[3] * s[1]) * sc, (v0[3] * c[1] + v0[2] * s[1]) * sc);
                    w.z = cvt_pk_bf16((v1[0] * c[2] - v1[1] * s[2]) * sc, (v1[1] * c[2] + v1[0] * s[2]) * sc);
                    w.w = cvt_pk_bf16((v1[2] * c[3] - v1[3] * s[3]) * sc, (v1[3] * c[3] + v1[2] * s[3]) * sc);
                    *(u32x4*)(base + (size_t)row * ld + colr0 + bj * 128) = w; } }
        } else {
#pragma unroll
            for (int ai = 0; ai < 2; ++ai)
#pragma unroll
                for (int m = 0; m < 4; ++m) { const int row = row0 + ai * 128 + m * 16;
#pragma unroll
                    for (int bj = 0; bj < 2; ++bj) *(u32x4*)(base + (size_t)row * ld + colr0 + bj * 128) = plain_pack(acc[ai][bj][m][0], acc[ai][bj][m][1]); }
        }
    }
};
struct EpiRes {
    static constexpr bool PERM = false, AFTER_DRAIN = false;
    float* out; const float* res;
    __device__ __forceinline__ void operator()(const f32x4 (&acc)[2][2][4][2], const Unit& u, int wr, int wc, int fr, int fq) const {
        const int row0 = u.pm * 256 + wr * 64 + fr, col0 = u.pn * 256 + wc * 32 + 4 * fq;
#pragma unroll
        for (int ai = 0; ai < 2; ++ai) {
            f32x4 r[4][2][2];
#pragma unroll
            for (int m = 0; m < 4; ++m)
#pragma unroll
                for (int bj = 0; bj < 2; ++bj)
#pragma unroll
                    for (int n = 0; n < 2; ++n) r[m][bj][n] = *(const f32x4*)(res + (size_t)(row0 + ai * 128 + m * 16) * DM + col0 + bj * 128 + n * 16);
            asm volatile("" ::: "memory");
#pragma unroll
            for (int m = 0; m < 4; ++m)
#pragma unroll
                for (int bj = 0; bj < 2; ++bj)
#pragma unroll
                    for (int n = 0; n < 2; ++n) *(f32x4*)(out + (size_t)(row0 + ai * 128 + m * 16) * DM + col0 + bj * 128 + n * 16) = acc[ai][bj][m][n] + r[m][bj][n];
        }
    }
};
struct EpiDelta {
    static constexpr bool PERM = true, AFTER_DRAIN = false;
    bf16_t* D;
    __device__ __forceinline__ void operator()(const f32x4 (&acc)[2][2][4][2], const Unit& u, int wr, int wc, int fr, int fq) const {
        const int colr0 = u.pn * 256 + wc * 32 + 8 * fq, row0 = u.pm * 256 + wr * 64 + fr;
#pragma unroll
        for (int ai = 0; ai < 2; ++ai)
#pragma unroll
            for (int m = 0; m < 4; ++m) { const int row = row0 + ai * 128 + m * 16;
#pragma unroll
                for (int bj = 0; bj < 2; ++bj) *(u32x4*)(D + (size_t)row * DM + colr0 + bj * 128) = plain_pack(acc[ai][bj][m][0], acc[ai][bj][m][1]); }
    }
};
template <class Epi> __device__ __forceinline__ void run_gemm(LAS unsigned char* lds, const bf16_t* A, const bf16_t* Bt, int M, int N, int K, const Epi& E) {
    Gemm g; g.A = A; g.Bt = Bt; g.M = M; g.N = N; g.K = K;
    StaticOrder S; S.init(M, N, (int)gridDim.x, (int)blockIdx.x);
    pg8::gemm_phase<Epi, StaticOrder, false>(lds, g, S, E, nullptr);
}

__device__ __forceinline__ void subln_gate_store(LAS unsigned char* lds, const float* __restrict__ g, float oscale, const bf16_t* __restrict__ gate, bf16_t* __restrict__ dst, int ld) {
    const int tid_ = mk_opaque_tid(), wid = tid_ >> 6, lane = tid_ & 63, cc = lane & 31;
    f32x4 g0 = *(const f32x4*)(g + cc * 8), g1 = *(const f32x4*)(g + cc * 8 + 4);
    u32x4 gt[8];
#pragma unroll
    for (int j = 0; j < 8; ++j) gt[j] = *(const u32x4*)(gate + (size_t)(16 * wid + 2 * j + (lane >> 5)) * ld + cc * 8);
    asm volatile("" ::: "memory");
#pragma unroll
    for (int j = 0; j < 8; ++j) {
        const int row = 16 * wid + 2 * j + (lane >> 5);
        const f32x4 a = *(const LAS f32x4*)(lds + (row * 256 + cc * 8) * 4), b = *(const LAS f32x4*)(lds + (row * 256 + cc * 8 + 4) * 4);
        float ss = a[0] * a[0] + a[1] * a[1] + a[2] * a[2] + a[3] * a[3] + b[0] * b[0] + b[1] * b[1] + b[2] * b[2] + b[3] * b[3];
#pragma unroll
        for (int o = 16; o >= 1; o >>= 1) ss += __shfl_xor(ss, o);
        const float rs = rsqrtf(ss * (1.0f / 256.0f) + 1e-5f) * oscale;
        float gg[8] = {bflo(gt[j].x), bfhi(gt[j].x), bflo(gt[j].y), bfhi(gt[j].y), bflo(gt[j].z), bfhi(gt[j].z), bflo(gt[j].w), bfhi(gt[j].w)};
        float y[8] = {a[0] * g0[0], a[1] * g0[1], a[2] * g0[2], a[3] * g0[3], b[0] * g1[0], b[1] * g1[1], b[2] * g1[2], b[3] * g1[3]};
#pragma unroll
        for (int e2 = 0; e2 < 8; ++e2) { const float sg = gg[e2] * __builtin_amdgcn_rcpf(1.0f + __expf(-gg[e2])); y[e2] = y[e2] * rs * sg; }
        u32x4 w; w.x = cvt_pk_bf16(y[0], y[1]); w.y = cvt_pk_bf16(y[2], y[3]); w.z = cvt_pk_bf16(y[4], y[5]); w.w = cvt_pk_bf16(y[6], y[7]);
        *(u32x4*)(dst + (size_t)row * ld + cc * 8) = w;
    }
}

constexpr float LOG2E = 1.4426950408889634f, ATHR = 8.0f;
__device__ __forceinline__ void partialSM(f32x16& p0, f32x16& p1, float& m_reg, float& mn, float& alpha) {
    float pmax = p0[0];
#pragma unroll
    for (int r = 1; r < 16; ++r) pmax = fmaxf(pmax, p0[r]);
#pragma unroll
    for (int r = 0; r < 16; ++r) pmax = fmaxf(pmax, p1[r]);
    { auto rr = __builtin_amdgcn_permlane32_swap(__float_as_uint(pmax), __float_as_uint(pmax), false, false); pmax = fmaxf(__uint_as_float(rr[0]), __uint_as_float(rr[1])); }
    if (__builtin_expect(__all(pmax - m_reg <= ATHR), 1)) { mn = m_reg; alpha = 1.f; }
    else { mn = fmaxf(m_reg, pmax); alpha = __builtin_amdgcn_exp2f((m_reg - mn) * LOG2E); m_reg = mn; }
    const float mnC = -mn * LOG2E;
#pragma unroll
    for (int r = 0; r < 16; ++r) p0[r] = __builtin_amdgcn_exp2f(fmaf(p0[r], LOG2E, mnC));
#pragma unroll
    for (int r = 0; r < 16; ++r) p1[r] = __builtin_amdgcn_exp2f(fmaf(p1[r], LOG2E, mnC));
}
__device__ __forceinline__ void finishSM(f32x16& p0, f32x16& p1, float alpha, float& l_reg, bf16x8& pa0, bf16x8& pa1, bf16x8& pa2, bf16x8& pa3) {
    float ps = 0;
#pragma unroll
    for (int r = 0; r < 16; ++r) ps += p0[r];
#pragma unroll
    for (int r = 0; r < 16; ++r) ps += p1[r];
    { auto rr = __builtin_amdgcn_permlane32_swap(__float_as_uint(ps), __float_as_uint(ps), false, false); ps = __uint_as_float(rr[0]) + __uint_as_float(rr[1]); }
    l_reg = l_reg * alpha + ps;
    PK4(p0, 0, pa0); PK4(p0, 8, pa1); PK4(p1, 0, pa2); PK4(p1, 8, pa3);
}
template <int D0> __device__ __forceinline__ void pv_one(f32x16& od, unsigned vb, bf16x8 pa0, bf16x8 pa1, bf16x8 pa2, bf16x8 pa3) {
    const s16x4 l0 = tr_read<D0 * 512 + 0 * 8192>(vb), h0 = tr_read<D0 * 512 + 0 * 8192 + 4096>(vb), l1 = tr_read<D0 * 512 + 1 * 8192>(vb), h1 = tr_read<D0 * 512 + 1 * 8192 + 4096>(vb);
    const s16x4 l2 = tr_read<D0 * 512 + 2 * 8192>(vb), h2 = tr_read<D0 * 512 + 2 * 8192 + 4096>(vb), l3 = tr_read<D0 * 512 + 3 * 8192>(vb), h3 = tr_read<D0 * 512 + 3 * 8192 + 4096>(vb);
    asm volatile("s_waitcnt lgkmcnt(0)" ::: "memory"); SBAR();
    od = __builtin_amdgcn_mfma_f32_32x32x16_bf16(pa0, PKLH(l0, h0), od, 0, 0, 0);
    od = __builtin_amdgcn_mfma_f32_32x32x16_bf16(pa1, PKLH(l1, h1), od, 0, 0, 0);
    od = __builtin_amdgcn_mfma_f32_32x32x16_bf16(pa2, PKLH(l2, h2), od, 0, 0, 0);
    od = __builtin_amdgcn_mfma_f32_32x32x16_bf16(pa3, PKLH(l3, h3), od, 0, 0, 0);
}

#define SBV() __builtin_amdgcn_sched_barrier(0x2 | 0x4 | 0x400)
__device__ __forceinline__ void smA(f32x16& p0, f32x16& p1, float& m_reg, float& alpha) {
    float pmax = p0[0];
#pragma unroll
    for (int r = 1; r < 16; ++r) pmax = fmaxf(pmax, p0[r]);
#pragma unroll
    for (int r = 0; r < 16; ++r) pmax = fmaxf(pmax, p1[r]);
    { auto rr = __builtin_amdgcn_permlane32_swap(__float_as_uint(pmax), __float_as_uint(pmax), false, false); pmax = fmaxf(__uint_as_float(rr[0]), __uint_as_float(rr[1])); }
    float mn;
    if (__builtin_expect(__all(pmax - m_reg <= ATHR), 1)) { mn = m_reg; alpha = 1.f; }
    else { mn = fmaxf(m_reg, pmax); alpha = __builtin_amdgcn_exp2f((m_reg - mn) * LOG2E); m_reg = mn; }
    const float mnC = -mn * LOG2E;
#pragma unroll
    for (int r = 0; r < 16; ++r) p0[r] = __builtin_amdgcn_exp2f(fmaf(p0[r], LOG2E, mnC));
#pragma unroll
    for (int r = 0; r < 16; ++r) p1[r] = fmaf(p1[r], LOG2E, mnC);
}
template <int D0, int KS0> __device__ __forceinline__ void pv_half(f32x16& oa, f32x16& ob, unsigned vb, bf16x8 paX, bf16x8 paY) {
    const s16x4 l0 = tr_read<D0 * 512 + KS0 * 8192>(vb), h0 = tr_read<D0 * 512 + KS0 * 8192 + 4096>(vb), l1 = tr_read<D0 * 512 + (KS0 + 1) * 8192>(vb), h1 = tr_read<D0 * 512 + (KS0 + 1) * 8192 + 4096>(vb);
    const s16x4 m0 = tr_read<(D0 + 1) * 512 + KS0 * 8192>(vb), n0 = tr_read<(D0 + 1) * 512 + KS0 * 8192 + 4096>(vb), m1 = tr_read<(D0 + 1) * 512 + (KS0 + 1) * 8192>(vb), n1 = tr_read<(D0 + 1) * 512 + (KS0 + 1) * 8192 + 4096>(vb);
    asm volatile("s_waitcnt lgkmcnt(0)" ::: "memory"); SBV();
    oa = __builtin_amdgcn_mfma_f32_32x32x16_bf16(paX, PKLH(l0, h0), oa, 0, 0, 0);
    oa = __builtin_amdgcn_mfma_f32_32x32x16_bf16(paY, PKLH(l1, h1), oa, 0, 0, 0);
    ob = __builtin_amdgcn_mfma_f32_32x32x16_bf16(paX, PKLH(m0, n0), ob, 0, 0, 0);
    ob = __builtin_amdgcn_mfma_f32_32x32x16_bf16(paY, PKLH(m1, n1), ob, 0, 0, 0);
}
__device__ __forceinline__ void attn_phase(const Params& P, LAS unsigned char* lds) {
    constexpr int NT = SEQ / 64;
    for (int it = blockIdx.x; it < GSEQ * 8 * 32; it += gridDim.x) {
        const int tid = mk_opaque_tid(), wid = __builtin_amdgcn_readfirstlane(tid >> 6), lane = tid & 63, r32 = lane & 31, hi = lane >> 5;
        const int map = wid >> 2, wq = wid & 3;
        bf16_t* qbuf = (bf16_t*)(P.ws + OFF_BIG); const bf16_t* kbuf = qbuf + (size_t)MR * 2048; const bf16_t* vbuf = kbuf + (size_t)MR * 2048; const bf16_t* gbuf = vbuf + (size_t)MR * 2048;
        const unsigned lds0 = (unsigned)(size_t)lds;
        LAS float* li_l = (LAS float*)(lds + 131072 + wid * 256); LAS float* al_l = li_l + 32;
        const unsigned kL = (unsigned)((4 * wid + (lane >> 4)) * 2048 + (((lane & 15) ^ (4 * (wid & 1) + (lane >> 4))) * 8)) * 2u;
        const unsigned vL = (unsigned)((8 * ((lane >> 4) & 1) + 4 * (wid >> 2) + ((lane >> 2) & 3)) * 2048 + (2 * (wid & 3) + (lane >> 5)) * 32 + (lane & 3) * 8) * 2u;
        const int head = it & 7, qblk = (it >> 3) & 31, seq = it >> 8;
        const size_t tok0 = (size_t)seq * SEQ;
        const char* kb = (const char*)(kbuf + tok0 * 2048 + (2 * head) * 128);
        const char* vb = (const char*)(vbuf + tok0 * 2048 + head * 256);
#define AT_PIECE(i, sbase, ko_, vo_) do { \
        if ((i) == 0) __builtin_amdgcn_global_load_lds((const unsigned*)(kb + (ko_)), (LAS unsigned*)(sbase), 16, 0, 2); \
        if ((i) == 1) __builtin_amdgcn_global_load_lds((const unsigned*)(kb + ((ko_) + 32u * 4096u)), (LAS unsigned*)((sbase) + 8192), 16, 0, 2); \
        if ((i) == 2) __builtin_amdgcn_global_load_lds((const unsigned*)(kb + ((ko_) + 256u)), (LAS unsigned*)((sbase) + 16384), 16, 0, 2); \
        if ((i) == 3) __builtin_amdgcn_global_load_lds((const unsigned*)(kb + ((ko_) + 256u + 32u * 4096u)), (LAS unsigned*)((sbase) + 16384 + 8192), 16, 0, 2); \
        if ((i) == 4) __builtin_amdgcn_global_load_lds((const unsigned*)(vb + (vo_)), (LAS unsigned*)((sbase) + 32768), 16, 0, 2); \
        if ((i) == 5) __builtin_amdgcn_global_load_lds((const unsigned*)(vb + ((vo_) + 16u * 4096u)), (LAS unsigned*)((sbase) + 32768 + 8192), 16, 0, 2); \
        if ((i) == 6) __builtin_amdgcn_global_load_lds((const unsigned*)(vb + ((vo_) + 32u * 4096u)), (LAS unsigned*)((sbase) + 32768 + 16384), 16, 0, 2); \
        if ((i) == 7) __builtin_amdgcn_global_load_lds((const unsigned*)(vb + ((vo_) + 48u * 4096u)), (LAS unsigned*)((sbase) + 32768 + 24576), 16, 0, 2); } while (0)
#define AT_ISSUE(st, k0) do { LAS unsigned char* s_ = lds + (st) * 65536 + wid * 1024; const unsigned ko_ = kL + (unsigned)(k0) * 4096u, vo_ = vL + (unsigned)(k0) * 4096u; \
        AT_PIECE(0, s_, ko_, vo_); AT_PIECE(1, s_, ko_, vo_); AT_PIECE(2, s_, ko_, vo_); AT_PIECE(3, s_, ko_, vo_); AT_PIECE(4, s_, ko_, vo_); AT_PIECE(5, s_, ko_, vo_); AT_PIECE(6, s_, ko_, vo_); AT_PIECE(7, s_, ko_, vo_); } while (0)
        const size_t qrow0 = tok0 + qblk * 128;
        bf16x8 qr[8];
        { const bf16_t* qp = qbuf + (qrow0 + wq * 32 + r32) * 2048 + (2 * head + map) * 128 + hi * 8;
#pragma unroll
          for (int d0 = 0; d0 < 8; ++d0) qr[d0] = *(const bf16x8*)(qp + d0 * 16); }
        AT_ISSUE(0, 0);
        asm volatile("s_waitcnt vmcnt(0)" ::: "memory"); MK_BAR();
        float m_reg = -1e30f, l_reg = 0.f; f32x16 o[8];
#pragma unroll
        for (int d = 0; d < 8; ++d) o[d] = f32x16{};
        for (int j = 0; j < NT; ++j) {
            const unsigned st = (unsigned)(j & 1) * 65536u;
            f32x16 p0 = f32x16{}, p1 = f32x16{};
            { const LAS unsigned char* Ks = lds + st + map * 16384;
              const bool more = j + 1 < NT;
              LAS unsigned char* sn_ = lds + (65536u - st) + wid * 1024; const unsigned kon_ = kL + (unsigned)(j + 1) * (64u * 4096u), von_ = vL + (unsigned)(j + 1) * (64u * 4096u);
#pragma unroll
              for (int d0 = 0; d0 < 8; ++d0) { const int cb = (d0 * 16 + hi * 8) * 2;
                  const bf16x8 b0 = *(const LAS bf16x8*)(Ks + KSWZ(r32, cb)); const bf16x8 b1 = *(const LAS bf16x8*)(Ks + 8192 + KSWZ(r32, cb));
                  p0 = __builtin_amdgcn_mfma_f32_32x32x16_bf16(b0, qr[d0], p0, 0, 0, 0);
                  p1 = __builtin_amdgcn_mfma_f32_32x32x16_bf16(b1, qr[d0], p1, 0, 0, 0);
                  if (more) AT_PIECE(d0, sn_, kon_, von_);
                  SBAR(); } }
            float al; smA(p0, p1, m_reg, al);
            if (__any(al < 1.f)) { if (hi == 0) al_l[r32] = al; asm volatile("s_waitcnt lgkmcnt(0)" ::: "memory");
#pragma unroll
                for (int r = 0; r < 16; ++r) { const float a = al_l[crow(r, hi)];
#pragma unroll
                    for (int d = 0; d < 8; ++d) o[d][r] *= a; } }
            bf16x8 pa0, pa1, pa2, pa3; float ps = 0.f;
#pragma unroll
            for (int r = 0; r < 16; ++r) ps += p0[r];
            PK4(p0, 0, pa0); PK4(p0, 8, pa1);
            const unsigned vb0 = lds0 + st + 32768u + (unsigned)v_rd_base(lane);
#define PVR(G, D0, KS0) const s16x4 G##l0 = tr_read<(D0) * 512 + (KS0) * 8192>(vb0), G##h0 = tr_read<(D0) * 512 + (KS0) * 8192 + 4096>(vb0), G##l1 = tr_read<(D0) * 512 + ((KS0) + 1) * 8192>(vb0), G##h1 = tr_read<(D0) * 512 + ((KS0) + 1) * 8192 + 4096>(vb0), \
                G##m0 = tr_read<((D0) + 1) * 512 + (KS0) * 8192>(vb0), G##n0 = tr_read<((D0) + 1) * 512 + (KS0) * 8192 + 4096>(vb0), G##m1 = tr_read<((D0) + 1) * 512 + ((KS0) + 1) * 8192>(vb0), G##n1 = tr_read<((D0) + 1) * 512 + ((KS0) + 1) * 8192 + 4096>(vb0)
#define PVM(G, OA, OB, PX, PY) do { asm volatile("s_waitcnt lgkmcnt(0)" ::: "memory"); SBAR(); \
                OA = __builtin_amdgcn_mfma_f32_32x32x16_bf16(PX, PKLH(G##l0, G##h0), OA, 0, 0, 0); OA = __builtin_amdgcn_mfma_f32_32x32x16_bf16(PY, PKLH(G##l1, G##h1), OA, 0, 0, 0); \
                OB = __builtin_amdgcn_mfma_f32_32x32x16_bf16(PX, PKLH(G##m0, G##n0), OB, 0, 0, 0); OB = __builtin_amdgcn_mfma_f32_32x32x16_bf16(PY, PKLH(G##m1, G##n1), OB, 0, 0, 0); } while (0)
            PVR(ga, 0, 0);
            PVM(ga, o[0], o[1], pa0, pa1); PVR(gb, 2, 0);
#pragma unroll
            for (int r = 0; r < 4; ++r) { p1[r] = __builtin_amdgcn_exp2f(p1[r]); ps += p1[r]; }
            PVM(gb, o[2], o[3], pa0, pa1); PVR(gc, 4, 0);
#pragma unroll
            for (int r = 4; r < 8; ++r) { p1[r] = __builtin_amdgcn_exp2f(p1[r]); ps += p1[r]; }
            PK4(p1, 0, pa2);
            PVM(gc, o[4], o[5], pa0, pa1); PVR(gd, 6, 0);
#pragma unroll
            for (int r = 8; r < 12; ++r) { p1[r] = __builtin_amdgcn_exp2f(p1[r]); ps += p1[r]; }
            PVM(gd, o[6], o[7], pa0, pa1); PVR(ge, 0, 2);
#pragma unroll
            for (int r = 12; r < 16; ++r) { p1[r] = __builtin_amdgcn_exp2f(p1[r]); ps += p1[r]; }
            PK4(p1, 8, pa3);
            { auto rr = __builtin_amdgcn_permlane32_swap(__float_as_uint(ps), __float_as_uint(ps), false, false); ps = __uint_as_float(rr[0]) + __uint_as_float(rr[1]); }
            l_reg = l_reg * al + ps;
            PVM(ge, o[0], o[1], pa2, pa3); PVR(gf, 2, 2);
            PVM(gf, o[2], o[3], pa2, pa3); PVR(gg, 4, 2);
            PVM(gg, o[4], o[5], pa2, pa3); PVR(gh, 6, 2);
            PVM(gh, o[6], o[7], pa2, pa3);
#undef PVR
#undef PVM
            asm volatile("s_waitcnt vmcnt(0)" ::: "memory"); MK_BAR();
        }
#undef AT_ISSUE
#undef AT_PIECE
        float lam;
        { float a = P.lq1[lane] * P.lk1[lane] + P.lq1[lane + 64] * P.lk1[lane + 64], b = P.lq2[lane] * P.lk2[lane] + P.lq2[lane + 64] * P.lk2[lane + 64];
    #pragma unroll
          for (int o = 32; o >= 1; o >>= 1) { a += __shfl_xor(a, o); b += __shfl_xor(b, o); }
          lam = __expf(a) - __expf(b) + 0.2f; }
        if (hi == 0) li_l[r32] = l_reg; asm volatile("s_waitcnt lgkmcnt(0)" ::: "memory");
        LAS unsigned char* reg = lds + wq * 32768;
        if (map == 1) {
#pragma unroll
            for (int r = 0; r < 16; ++r) { const float s = lam * __builtin_amdgcn_rcpf(li_l[crow(r, hi)]);
#pragma unroll
                for (int d = 0; d < 8; ++d) *(LAS float*)(reg + ((d * 16 + r) * 64 + lane) * 4) = o[d][r] * s; }
        }
        MK_BAR();
        if (map == 0) {
#pragma unroll
            for (int r = 0; r < 16; ++r) { const float s = __builtin_amdgcn_rcpf(li_l[crow(r, hi)]);
#pragma unroll
                for (int d = 0; d < 8; ++d) o[d][r] = o[d][r] * s - *(const LAS float*)(reg + ((d * 16 + r) * 64 + lane) * 4); }
            asm volatile("s_waitcnt lgkmcnt(0)" ::: "memory");
#pragma unroll
            for (int r = 0; r < 16; ++r)
#pragma unroll
                for (int d = 0; d < 8; ++d) *(LAS float*)(reg + (crow(r, hi) * 256 + d * 32 + r32) * 4) = o[d][r];
        }
        MK_BAR();
        subln_gate_store(lds, P.da_subln_g, 0.8f, gbuf + qrow0 * 2048 + head * 256, qbuf + qrow0 * 2048 + head * 256, 2048);
        MK_BAR();
    }
}

__device__ __forceinline__ void ret_chain_phase(const Params& P, LAS unsigned char* lds) {
    const int tid = mk_opaque_tid(), wid = __builtin_amdgcn_readfirstlane(tid >> 6), lane = tid & 63, r32 = lane & 31, hi = lane >> 5;
    const int sr = tid >> 4, sc = (tid & 15) * 8, m0 = wid & 3, nb0 = 2 * (wid >> 2);
    const bf16_t* rk = (const bf16_t*)(P.ws + OFF_RK); const bf16_t* rv = (const bf16_t*)(P.ws + OFF_RV);
    const unsigned lds0 = (unsigned)(size_t)lds;
    const unsigned abase = lds0 + (unsigned)v_rd_base(lane) + (unsigned)m0 * 512u, bbase = lds0 + 32768u + (unsigned)v_rd_base(lane) + (unsigned)nb0 * 512u;
    for (int cid = blockIdx.x; cid < GSEQ * 8 * 4; cid += gridDim.x) {
        const int dvh = cid & 1, dir = (cid >> 1) & 1, head = (cid >> 2) & 7, seq = cid >> 5;
        const float lg = -__expf((dir ? P.ret_decay_bwd : P.ret_decay_fwd)[head]) * LOG2E;
        const float cdec = __builtin_amdgcn_exp2f(128.f * lg);
        const bf16_t* kb = rk + (size_t)seq * SEQ * 1024 + head * 128 + sc;
        const bf16_t* vb = rv + (size_t)seq * SEQ * 2048 + head * 256 + dvh * 128 + sc;
        bf16_t* Sbase = (bf16_t*)(P.ws + (dir ? OFF_SB : OFF_SF)) + (size_t)((seq * 8 + head) * 32) * 32768;
        f32x16 acc[2]; acc[0] = f32x16{}; acc[1] = f32x16{};
        bf16x8 kreg[4], vreg[4];
        int c = dir ? 31 : 0;
#pragma unroll
        for (int i = 0; i < 4; ++i) { kreg[i] = *(const bf16x8*)(kb + (size_t)(c * 128 + sr + 32 * i) * 1024); vreg[i] = *(const bf16x8*)(vb + (size_t)(c * 128 + sr + 32 * i) * 2048); }
#define CH_STORE(cc_) do { bf16_t* Sc = Sbase + (size_t)(cc_) * 32768; \
            _Pragma("unroll") for (int nb = 0; nb < 2; ++nb) _Pragma("unroll") for (int q4 = 0; q4 < 4; ++q4) { const int dv = dvh * 128 + 32 * (nb0 + nb) + r32, dk = 32 * m0 + 8 * q4 + 4 * hi; \
                uint2 w; w.x = cvt_pk_bf16(acc[nb][4 * q4 + 0], acc[nb][4 * q4 + 1]); w.y = cvt_pk_bf16(acc[nb][4 * q4 + 2], acc[nb][4 * q4 + 3]); *(uint2*)(Sc + dv * 128 + dk) = w; } } while (0)
        CH_STORE(c);
        for (int s = 0; s < 31; ++s) {
#pragma unroll
            for (int i = 0; i < 4; ++i) { const int j = sr + 32 * i; const float f = __builtin_amdgcn_exp2f(lg * (float)(dir ? j : 127 - j));
                *(LAS bf16x8*)(lds + v_st<4>(j, sc)) = scale8(kreg[i], f); *(LAS bf16x8*)(lds + 32768 + v_st<4>(j, sc)) = vreg[i]; }
            const int cn = dir ? c - 1 : c + 1;
            if (s + 1 < 31) {
#pragma unroll
                for (int i = 0; i < 4; ++i) { kreg[i] = *(const bf16x8*)(kb + (size_t)(cn * 128 + sr + 32 * i) * 1024); vreg[i] = *(const bf16x8*)(vb + (size_t)(cn * 128 + sr + 32 * i) * 2048); } }
            __syncthreads();
#pragma unroll
            for (int r = 0; r < 16; ++r) { acc[0][r] *= cdec; acc[1][r] *= cdec; }
#define CH_STEP(KS) do { const s16x4 al_ = tr_read<(KS) * 4096>(abase), ah_ = tr_read<(KS) * 4096 + 2048>(abase); \
                const s16x4 b0l_ = tr_read<(KS) * 4096>(bbase), b0h_ = tr_read<(KS) * 4096 + 2048>(bbase), b1l_ = tr_read<512 + (KS) * 4096>(bbase), b1h_ = tr_read<512 + (KS) * 4096 + 2048>(bbase); \
                asm volatile("s_waitcnt lgkmcnt(0)" ::: "memory"); SBAR(); \
                acc[0] = __builtin_amdgcn_mfma_f32_32x32x16_bf16(PKLH(al_, ah_), PKLH(b0l_, b0h_), acc[0], 0, 0, 0); \
                acc[1] = __builtin_amdgcn_mfma_f32_32x32x16_bf16(PKLH(al_, ah_), PKLH(b1l_, b1h_), acc[1], 0, 0, 0); } while (0)
            CH_STEP(0); CH_STEP(1); CH_STEP(2); CH_STEP(3); CH_STEP(4); CH_STEP(5); CH_STEP(6); CH_STEP(7);
#undef CH_STEP
            __syncthreads();
            c = cn;
            CH_STORE(c);
        }
#undef CH_STORE
    }
}

template <int D0> __device__ __forceinline__ void ro_pv(f32x16& od, unsigned vb, const bf16x8 (&pa)[8]) {
    const s16x4 l0 = tr_read<D0 * 512 + 0 * 8192>(vb), h0 = tr_read<D0 * 512 + 0 * 8192 + 4096>(vb), l1 = tr_read<D0 * 512 + 1 * 8192>(vb), h1 = tr_read<D0 * 512 + 1 * 8192 + 4096>(vb);
    const s16x4 l2 = tr_read<D0 * 512 + 2 * 8192>(vb), h2 = tr_read<D0 * 512 + 2 * 8192 + 4096>(vb), l3 = tr_read<D0 * 512 + 3 * 8192>(vb), h3 = tr_read<D0 * 512 + 3 * 8192 + 4096>(vb);
    const s16x4 l4 = tr_read<D0 * 512 + 4 * 8192>(vb), h4 = tr_read<D0 * 512 + 4 * 8192 + 4096>(vb), l5 = tr_read<D0 * 512 + 5 * 8192>(vb), h5 = tr_read<D0 * 512 + 5 * 8192 + 4096>(vb);
    const s16x4 l6 = tr_read<D0 * 512 + 6 * 8192>(vb), h6 = tr_read<D0 * 512 + 6 * 8192 + 4096>(vb), l7 = tr_read<D0 * 512 + 7 * 8192>(vb), h7 = tr_read<D0 * 512 + 7 * 8192 + 4096>(vb);
    asm volatile("s_waitcnt lgkmcnt(0)" ::: "memory"); SBAR();
    od = __builtin_amdgcn_mfma_f32_32x32x16_bf16(pa[0], PKLH(l0, h0), od, 0, 0, 0); od = __builtin_amdgcn_mfma_f32_32x32x16_bf16(pa[1], PKLH(l1, h1), od, 0, 0, 0);
    od = __builtin_amdgcn_mfma_f32_32x32x16_bf16(pa[2], PKLH(l2, h2), od, 0, 0, 0); od = __builtin_amdgcn_mfma_f32_32x32x16_bf16(pa[3], PKLH(l3, h3), od, 0, 0, 0);
    od = __builtin_amdgcn_mfma_f32_32x32x16_bf16(pa[4], PKLH(l4, h4), od, 0, 0, 0); od = __builtin_amdgcn_mfma_f32_32x32x16_bf16(pa[5], PKLH(l5, h5), od, 0, 0, 0);
    od = __builtin_amdgcn_mfma_f32_32x32x16_bf16(pa[6], PKLH(l6, h6), od, 0, 0, 0); od = __builtin_amdgcn_mfma_f32_32x32x16_bf16(pa[7], PKLH(l7, h7), od, 0, 0, 0);
}
__device__ __forceinline__ void ret_out_phase(const Params& P, LAS unsigned char* lds) {
    for (int it = blockIdx.x; it < GSEQ * 8 * 32; it += gridDim.x) {
        const int tid = mk_opaque_tid(), wid = __builtin_amdgcn_readfirstlane(tid >> 6), lane = tid & 63, r32 = lane & 31, hi = lane >> 5;
        const int wq = wid & 3, wh = wid >> 2;
        const bf16_t* rq = (const bf16_t*)(P.ws + OFF_RQ); const bf16_t* rk = (const bf16_t*)(P.ws + OFF_RK); bf16_t* rv = (bf16_t*)(P.ws + OFF_RV); const bf16_t* rg = (const bf16_t*)(P.ws + OFF_RG);
        const bf16_t* SF = (const bf16_t*)(P.ws + OFF_SF); const bf16_t* SB = (const bf16_t*)(P.ws + OFF_SB);
        const unsigned lds0 = (unsigned)(size_t)lds;
        LAS unsigned char* bufA = lds; LAS unsigned char* bufB = lds + 65536;
        const int rowL = 4 * wid + (lane >> 4), chL = ((lane & 15) ^ (4 * (wid & 1) + (lane >> 4))) * 8;
        const unsigned kL = (unsigned)(rowL * 1024 + chL) * 2u, sL = (unsigned)(rowL * 128 + chL) * 2u;
        const unsigned vL = (unsigned)((8 * ((lane >> 4) & 1) + 4 * (wid >> 2) + ((lane >> 2) & 3)) * 2048 + (2 * (wid & 3) + (lane >> 5)) * 32 + (lane & 3) * 8) * 2u;
        const int chunk = it & 31, head = (it >> 5) & 7, seq = it >> 8;
        const size_t tokc = (size_t)seq * SEQ + chunk * 128;
        const float lgf = -__expf(P.ret_decay_fwd[head]) * LOG2E, lgb = -__expf(P.ret_decay_bwd[head]) * LOG2E;
        const char* SfT = (const char*)(SF + (size_t)((seq * 8 + head) * 32 + chunk) * 32768); const char* SbT = (const char*)(SB + (size_t)((seq * 8 + head) * 32 + chunk) * 32768);
        const char* kbp = (const char*)(rk + tokc * 1024 + head * 128); const char* vbp = (const char*)(rv + tokc * 2048 + head * 256);
#pragma unroll
        for (int i = 0; i < 4; ++i) __builtin_amdgcn_global_load_lds((const unsigned*)(kbp + (kL + (unsigned)i * (32u * 2048u))), (LAS unsigned*)(bufB + i * 8192 + wid * 1024), 16, 0, 0);
#pragma unroll
        for (int i = 0; i < 8; ++i) __builtin_amdgcn_global_load_lds((const unsigned*)(vbp + (vL + (unsigned)i * (16u * 4096u))), (LAS unsigned*)(bufA + i * 8192 + wid * 1024), 16, 0, 0);
        bf16x8 qr[8];
        { const bf16_t* qp = rq + (tokc + wq * 32 + r32) * 1024 + head * 128 + hi * 8;
#pragma unroll
          for (int d0 = 0; d0 < 8; ++d0) qr[d0] = *(const bf16x8*)(qp + d0 * 16); }
        asm volatile("s_waitcnt vmcnt(0)" ::: "memory"); MK_BAR();
        const int n = 32 * wq + r32;
        bf16x8 pa[8];
#pragma unroll
        for (int kb = 0; kb < 4; ++kb) { f32x16 p = f32x16{};
#pragma unroll
            for (int d0 = 0; d0 < 8; ++d0) { const bf16x8 a = *(const LAS bf16x8*)(bufB + kb * 8192 + KSWZ(r32, (d0 * 16 + hi * 8) * 2)); p = __builtin_amdgcn_mfma_f32_32x32x16_bf16(a, qr[d0], p, 0, 0, 0); }
#pragma unroll
            for (int r = 0; r < 16; ++r) { const int d = n - (32 * kb + crow(r, hi)); const float e = d >= 0 ? (float)d * lgf : (float)(-d) * lgb; p[r] *= __builtin_amdgcn_exp2f(e); }
            PK4(p, 0, pa[2 * kb]); PK4(p, 8, pa[2 * kb + 1]); SBAR(); }
        MK_BAR();
#pragma unroll
        for (int i = 0; i < 8; ++i) __builtin_amdgcn_global_load_lds((const unsigned*)(SfT + (sL + (unsigned)i * 8192u)), (LAS unsigned*)(bufB + i * 8192 + wid * 1024), 16, 0, 2);
        f32x16 o[4];
#pragma unroll
        for (int d = 0; d < 4; ++d) o[d] = f32x16{};
        { const unsigned vb0 = lds0 + (unsigned)v_rd_base(lane) + (unsigned)(4 * wh) * 512u;
          ro_pv<0>(o[0], vb0, pa); ro_pv<1>(o[1], vb0, pa); ro_pv<2>(o[2], vb0, pa); ro_pv<3>(o[3], vb0, pa); }
        MK_BAR();
#pragma unroll
        for (int i = 0; i < 8; ++i) __builtin_amdgcn_global_load_lds((const unsigned*)(SbT + (sL + (unsigned)i * 8192u)), (LAS unsigned*)(bufA + i * 8192 + wid * 1024), 16, 0, 2);
        asm volatile("s_waitcnt vmcnt(8)" ::: "memory"); MK_BAR();
        { const float qs = __builtin_amdgcn_exp2f(lgf * (float)(n + 1));
#pragma unroll
          for (int ks = 0; ks < 8; ++ks) { const bf16x8 qf = scale8(qr[ks], qs);
#pragma unroll
              for (int d0 = 0; d0 < 4; ++d0) { const bf16x8 b = *(const LAS bf16x8*)(bufB + (128 * wh + 32 * d0) * 256 + KSWZ(r32, (16 * ks + 8 * hi) * 2)); o[d0] = __builtin_amdgcn_mfma_f32_32x32x16_bf16(qf, b, o[d0], 0, 0, 0); } } }
        asm volatile("s_waitcnt vmcnt(0)" ::: "memory"); MK_BAR();
        { const float qs = __builtin_amdgcn_exp2f(lgb * (float)(128 - n));
#pragma unroll
          for (int ks = 0; ks < 8; ++ks) { const bf16x8 qf = scale8(qr[ks], qs);
#pragma unroll
              for (int d0 = 0; d0 < 4; ++d0) { const bf16x8 b = *(const LAS bf16x8*)(bufA + (128 * wh + 32 * d0) * 256 + KSWZ(r32, (16 * ks + 8 * hi) * 2)); o[d0] = __builtin_amdgcn_mfma_f32_32x32x16_bf16(qf, b, o[d0], 0, 0, 0); } } }
        MK_BAR();
#pragma unroll
        for (int r = 0; r < 16; ++r)
#pragma unroll
            for (int d = 0; d < 4; ++d) *(LAS float*)(lds + ((32 * wq + crow(r, hi)) * 256 + 128 * wh + 32 * d + r32) * 4) = o[d][r];
        MK_BAR();
        subln_gate_store(lds, P.ret_subln_g, 1.0f, rg + tokc * 2048 + head * 256, rv + tokc * 2048 + head * 256, 2048);
        MK_BAR();
    }
}

__global__ void __launch_bounds__(512) mega(Params P) {
    extern __shared__ __attribute__((aligned(16))) unsigned char shm[];
    LAS unsigned char* lds = (LAS unsigned char*)shm;
    cg::grid_group grid = cg::this_grid();
    volatile LAS unsigned* xst = (volatile LAS unsigned*)(lds + LDS_BYTES - 16);
    if (threadIdx.x == 0) { xst[0] = 0u; xst[1] = 0u; }
    __syncthreads();
    const XcdBarrier xb = xcd_barrier_post((unsigned*)(P.ws + OFF_BAR), xst);
    bf16_t* H = (bf16_t*)(P.ws + OFF_H); bf16_t* big = (bf16_t*)(P.ws + OFF_BIG);
    const bf16_t* WinDA = (const bf16_t*)(P.ws + OFF_WIN_DA); const bf16_t* WoutDA = (const bf16_t*)(P.ws + OFF_WOUT_DA);
    const bf16_t* WinRET = (const bf16_t*)(P.ws + OFF_WIN_RET); const bf16_t* WoutRET = (const bf16_t*)(P.ws + OFF_WOUT_RET);
    const float* tab = (const float*)(P.ws + OFF_TAB);
    prep_phase(P, lds);
    norm_to_bf16(P.x_prompt, P.norm_g, H, MR);
    grid.sync();
    bf16_t* D0 = (bf16_t*)(P.ws + OFF_D0); bf16_t* D1 = (bf16_t*)(P.ws + OFF_D1);
    for (int r = 0; r < NROUND; ++r) {
        const float* xin = r < 2 ? P.x_prompt + (size_t)r * MR * DM : P.x_sample;
        float* xio = P.out + (size_t)r * MR * DM;
        { EpiDA E; E.big = big; E.tcos = tab; E.tsin = tab + 262144; run_gemm(lds, H, WinDA, MR, 8192, 1024, E); }
        if (r > 0) { const float* xp = (r - 1) < 2 ? P.x_prompt + (size_t)(r - 1) * MR * DM : P.x_sample; comb2_norm_out(xp, D0, D1, P.final_norm_g, P.out + (size_t)(r - 1) * MR * DM, MR); }
        xcd_barrier(xb);
        attn_phase(P, lds);
        xcd_barrier(xb);
        { EpiDelta E; E.D = D0; run_gemm(lds, big, WoutDA, MR, 1024, 2048, E); }
        xcd_barrier(xb);
        comb_norm_to_bf16(xin, D0, nullptr, P.norm_g + DM, H, MR);
        xcd_barrier(xb);
        { EpiRET E; E.rq = (bf16_t*)(P.ws + OFF_RQ); E.rk = (bf16_t*)(P.ws + OFF_RK); E.rv = (bf16_t*)(P.ws + OFF_RV); E.rg = (bf16_t*)(P.ws + OFF_RG); E.tcos = tab + 2 * 262144; E.tsin = tab + 3 * 262144;
          run_gemm(lds, H, WinRET, MR, 6144, 1024, E); }
        xcd_barrier(xb);
        ret_chain_phase(P, lds);
        xcd_barrier(xb);
        ret_out_phase(P, lds);
        xcd_barrier(xb);
        { EpiDelta E; E.D = D1; run_gemm(lds, (const bf16_t*)(P.ws + OFF_RV), WoutRET, MR, 1024, 2048, E); }
        if (r + 1 < NROUND) { const float* xn = (r + 1) < 2 ? P.x_prompt + (size_t)(r + 1) * MR * DM : P.x_sample; norm_to_bf16(xn, P.norm_g, H, MR); }
        xcd_barrier(xb);
    }
    comb2_norm_out(P.x_sample, D0, D1, P.final_norm_g, P.out + (size_t)(NROUND - 1) * MR * DM, MR);
}
}

extern "C" void kernel_launch(void* const* d_in, const int* in_sizes, int n_in, void* d_out, int out_size, void* d_ws, size_t ws_size, hipStream_t stream) {
    static int grid_blocks = 0;
    if (!grid_blocks) {
        if (hipFuncSetAttribute((const void*)mk::mega, hipFuncAttributeMaxDynamicSharedMemorySize, (int)mk::LDS_BYTES) != hipSuccess) fprintf(stderr, "kernel_launch: LDS attribute failed\n");
        int dev = 0, cus = 0, per = 0; hipGetDevice(&dev); hipDeviceGetAttribute(&cus, hipDeviceAttributeMultiprocessorCount, dev);
        hipOccupancyMaxActiveBlocksPerMultiprocessor(&per, mk::mega, 512, mk::LDS_BYTES);
        if (per < 1) fprintf(stderr, "kernel_launch: occupancy query says %d blocks/CU\n", per);
        grid_blocks = cus > 0 ? cus : 256;
    }
    mk::Params p{};
    p.x_prompt = (const float*)d_in[0]; p.x_sample = (const float*)d_in[1]; p.norm_g = (const float*)d_in[2]; p.da_w_in = (const float*)d_in[3];
    p.lq1 = (const float*)d_in[4]; p.lk1 = (const float*)d_in[5]; p.lq2 = (const float*)d_in[6]; p.lk2 = (const float*)d_in[7];
    p.da_subln_g = (const float*)d_in[8]; p.da_w_out = (const float*)d_in[9]; p.ret_w_in = (const float*)d_in[10]; p.ret_decay_fwd = (const float*)d_in[11];
    p.ret_decay_bwd = (const float*)d_in[12]; p.ret_subln_g = (const float*)d_in[13]; p.ret_w_out = (const float*)d_in[14]; p.final_norm_g = (const float*)d_in[15];
    p.out = (float*)d_out; p.ws = (unsigned char*)d_ws;
    if (hipMemsetAsync((unsigned char*)d_ws + mk::OFF_BAR, 0, (size_t)XCD_BAR_WORDS * 4, stream) != hipSuccess) fprintf(stderr, "kernel_launch: barrier memset failed\n");
    void* args[] = {&p};
    hipError_t e = hipLaunchCooperativeKernel((void*)mk::mega, dim3(grid_blocks), dim3(512), args, (unsigned)mk::LDS_BYTES, stream);
    if (e != hipSuccess) fprintf(stderr, "kernel_launch: cooperative launch failed: %s (grid %d)\n", hipGetErrorString(e), grid_blocks);
}
```

```cpp
#include <hip/hip_runtime.h>
#include <hip/hip_cooperative_groups.h>
#include <cstdio>
namespace cg = cooperative_groups;
__device__ __forceinline__ int mk_opaque_tid() { int t = threadIdx.x; asm volatile("" : "+v"(t)); return t; }
namespace pg8 {
#define PG8_LAS __attribute__((address_space(3)))
typedef unsigned short bf16_t;
typedef short bf16x8 __attribute__((ext_vector_type(8)));
typedef float f32x4 __attribute__((ext_vector_type(4)));
typedef unsigned u32x4 __attribute__((ext_vector_type(4)));
constexpr int BM = 256, BK = 64, HALF = 128, HTB = HALF * BK * 2  , STAGE_BYTES = 8 * HTB, NXCD = 8, WGM = 8;

__host__ __device__ __forceinline__ int lds_byte(int r, int c) { const int st = (r >> 4) * 2 + (c >> 5), rr = r & 15, cc = c & 31, ob = rr * 64 + cc * 2; return st * 1024 + (ob ^ (((ob >> 9) & 1) << 5)); }
__host__ __device__ __forceinline__ void stage_rc(int b, int& R, int& C) { const int st = b / 1024, sb = b % 1024, swz = sb ^ (((sb >> 9) & 1) << 5); R = (st >> 1) * 16 + swz / 64; C = (st & 1) * 32 + (swz % 64) / 2; }
__host__ __device__ __forceinline__ int perm32(int rho) { const int n = rho >> 4, i = rho & 15; return 8 * (i >> 2) + 4 * n + (i & 3); }

struct Unit { int pm, pn; };
struct Gemm { const bf16_t* A; const bf16_t* Bt; int M, N, K; };

struct StaticOrder {
    int nM, nN, nwg, G, c;
    __host__ __device__ void init(int M, int N, int G_, int c_) { nM = M / BM; nN = N / BM; nwg = nM * nN; G = G_; c = c_; }
    __host__ __device__ bool next(int i, Unit& u) const {
        const long L = (long)i * G + c; if (L >= nwg) return false;
        int wgid = (int)L; { const int q = nwg / NXCD, r = nwg % NXCD, xcd = wgid % NXCD, off = wgid / NXCD; wgid = (xcd < r ? xcd * (q + 1) : r * (q + 1) + (xcd - r) * q) + off; }
        const int nig = WGM * nN, gid = wgid / nig, fm = gid * WGM, gsz = (nM - fm) < WGM ? (nM - fm) : WGM;
        u.pm = fm + ((wgid % nig) % gsz); u.pn = (wgid % nig) / gsz; return true;
    }
    __device__ __forceinline__ void a_ready(const Unit&) const {}
    __device__ __forceinline__ void done(const Unit&) const {}
};
__device__ __forceinline__ unsigned cvt_pk_bf16(float lo, float hi) { unsigned r; asm volatile("v_cvt_pk_bf16_f32 %0, %1, %2" : "=v"(r) : "v"(lo), "v"(hi)); return r; }
template <class Epi, class Sched, bool STAMP = false>
__device__ __forceinline__ void gemm_phase(PG8_LAS unsigned char* lds, const Gemm g, const Sched& S, const Epi& E, unsigned long long* stamps) {
    const int tid = mk_opaque_tid(), wid = __builtin_amdgcn_readfirstlane(tid >> 6), lane = tid & 63, wr = wid >> 2, wc = wid & 3, fr = lane & 15, fq = lane >> 4;
    const int K = g.K, nt = K / BK;
    int ts_lo = 0, ts_hi = 0, nts = 0; const unsigned long long rt_entry = STAMP ? (unsigned long long)wall_clock64() : 0ull;
#define PG8_STAMP() do { if (STAMP && wid == 0 && nts < 64) { const unsigned long long _c = (unsigned long long)clock64(); \
        ts_lo = (lane == nts) ? (int)(unsigned)_c : ts_lo; ts_hi = (lane == nts) ? (int)(unsigned)(_c >> 32) : ts_hi; ++nts; } } while (0)
    PG8_STAMP();
    unsigned voffA[2], voffB[2];
#pragma unroll
    for (int i = 0; i < 2; ++i) { int R, C; stage_rc(tid * 16 + i * 8192, R, C); const int Rb = Epi::PERM ? ((R & ~31) + perm32(R & 31)) : R;
        voffA[i] = (unsigned)(R * K + C) * 2u; voffB[i] = (unsigned)(Rb * K + C) * 2u; }
    const size_t kstep = (size_t)(BK * 2);
    const size_t hstep = (size_t)HALF * K * 2;
    const size_t tstep = 2 * hstep;
    const unsigned ldsw = (unsigned)wid * 1024u;
    const int aoff = lds_byte(wr * 64 + fr, fq * 8), boff = lds_byte(wc * 32 + fr, fq * 8);
#define PG8_SA(b, h) (((b) * 2 + (h)) * HTB)
#define PG8_SB(b, h) ((4 + (b) * 2 + (h)) * HTB)
#define PG8_STAGE(bufoff, gbase, voff) do { _Pragma("unroll") for (int _i = 0; _i < 2; ++_i) \
        __builtin_amdgcn_global_load_lds((const unsigned*)((const char*)(gbase) + (voff)[_i]), (PG8_LAS unsigned*)(lds + (bufoff) + ldsw + _i * 8192), 16, 0, 0); } while (0)
#define PG8_LDA(dst, b, h) do { _Pragma("unroll") for (int m = 0; m < 4; ++m) _Pragma("unroll") for (int k = 0; k < 2; ++k) dst[m][k] = *(const PG8_LAS bf16x8*)(lds + PG8_SA(b, h) + aoff + m * 2048 + k * 1024); } while (0)
#define PG8_LDB(dst, b, h) do { _Pragma("unroll") for (int n = 0; n < 2; ++n) _Pragma("unroll") for (int k = 0; k < 2; ++k) dst[n][k] = *(const PG8_LAS bf16x8*)(lds + PG8_SB(b, h) + boff + n * 2048 + k * 1024); } while (0)
#define PG8_MMA(ai, bj, At, Bt) do { __builtin_amdgcn_s_setprio(1); _Pragma("unroll") for (int m = 0; m < 4; ++m) _Pragma("unroll") for (int n = 0; n < 2; ++n) _Pragma("unroll") for (int k = 0; k < 2; ++k) \
        acc[ai][bj][m][n] = __builtin_amdgcn_mfma_f32_16x16x32_bf16(Bt[n][k], At[m][k], acc[ai][bj][m][n], 0, 0, 0); __builtin_amdgcn_s_setprio(0); } while (0)
#define PG8_WAIT_V(n) asm volatile("s_waitcnt vmcnt(" #n ")" ::: "memory")
#define PG8_WAIT_L(n) asm volatile("s_waitcnt lgkmcnt(" #n ")" ::: "memory")
#define PG8_BAR __builtin_amdgcn_s_barrier()
#define PG8_SCHED __builtin_amdgcn_sched_barrier(0)
    Unit cur, nxt; int ui = 0;
    if (!S.next(0, cur)) return;
    f32x4 acc[2][2][4][2];
#pragma unroll
    for (int a = 0; a < 2; ++a)
#pragma unroll
        for (int b = 0; b < 2; ++b)
#pragma unroll
            for (int m = 0; m < 4; ++m)
#pragma unroll
                for (int n = 0; n < 2; ++n) acc[a][b][m][n] = (f32x4){0.f, 0.f, 0.f, 0.f};
    bf16x8 At[4][2], B0[2][2], B1[2][2];
    const char* cA = (const char*)g.A + (size_t)cur.pm * tstep; const char* cB = (const char*)g.Bt + (size_t)cur.pn * tstep;
    S.a_ready(cur);
    PG8_STAGE(PG8_SB(0, 0), cB, voffB); PG8_STAGE(PG8_SA(0, 0), cA, voffA); PG8_STAGE(PG8_SB(0, 1), cB + hstep, voffB); PG8_STAGE(PG8_SA(0, 1), cA + hstep, voffA);
    if (wr == 1) PG8_BAR;
    PG8_WAIT_V(4); PG8_BAR;
    PG8_STAGE(PG8_SB(1, 0), cB + kstep, voffB); PG8_STAGE(PG8_SA(1, 0), cA + kstep, voffA); PG8_STAGE(PG8_SB(1, 1), cB + hstep + kstep, voffB);
    PG8_WAIT_V(6); PG8_BAR;
    PG8_STAMP();
    for (;;) {
        const bool has_next = S.next(ui + 1, nxt);
        const char* nA = has_next ? (const char*)g.A + (size_t)nxt.pm * tstep : cA; const char* nB = has_next ? (const char*)g.Bt + (size_t)nxt.pn * tstep : cB;
        for (int t = 0; t < nt; t += 2) {
            const bool last = (t == nt - 2);
            const char* a1 = cA + (size_t)(t + 1) * kstep;
            const char* a2 = last ? nA : cA + (size_t)(t + 2) * kstep; const char* b2 = last ? nB : cB + (size_t)(t + 2) * kstep;
            const char* a3 = a2 + kstep; const char* b3 = b2 + kstep;
            if (last && has_next) S.a_ready(nxt);
            PG8_LDB(B0, 0, 0); PG8_SCHED; PG8_LDA(At, 0, 0); PG8_STAGE(PG8_SA(1, 1), a1 + hstep, voffA);
            PG8_WAIT_L(8); PG8_BAR; PG8_WAIT_L(0); PG8_MMA(0, 0, At, B0); PG8_BAR; PG8_SCHED;
            PG8_LDB(B1, 0, 1); PG8_STAGE(PG8_SB(0, 0), b2, voffB);
            PG8_BAR; PG8_WAIT_L(0); PG8_MMA(0, 1, At, B1); PG8_BAR;
            PG8_LDA(At, 0, 1); PG8_STAGE(PG8_SA(0, 0), a2, voffA);
            PG8_BAR; PG8_WAIT_L(0); PG8_MMA(1, 0, At, B0); PG8_BAR; PG8_SCHED;
            PG8_STAGE(PG8_SB(0, 1), b2 + hstep, voffB);
            PG8_WAIT_V(6); PG8_BAR; PG8_MMA(1, 1, At, B1); PG8_BAR;
            PG8_LDB(B0, 1, 0); PG8_SCHED; PG8_LDA(At, 1, 0); PG8_STAGE(PG8_SA(0, 1), a2 + hstep, voffA);
            PG8_WAIT_L(8); PG8_BAR; PG8_WAIT_L(0); PG8_MMA(0, 0, At, B0); PG8_BAR; PG8_SCHED;
            PG8_LDB(B1, 1, 1); PG8_STAGE(PG8_SB(1, 0), b3, voffB);
            PG8_BAR; PG8_WAIT_L(0); PG8_MMA(0, 1, At, B1); PG8_BAR;
            PG8_LDA(At, 1, 1); PG8_STAGE(PG8_SA(1, 0), a3, voffA);
            PG8_BAR; PG8_WAIT_L(0); PG8_MMA(1, 0, At, B0); PG8_BAR; PG8_SCHED;
            PG8_STAGE(PG8_SB(1, 1), b3 + hstep, voffB);
            PG8_WAIT_V(6); PG8_BAR; PG8_MMA(1, 1, At, B1); PG8_BAR;
        }
        PG8_STAMP();
        if constexpr (!Epi::AFTER_DRAIN) { E(acc, cur, wr, wc, fr, fq); S.done(cur); }
        PG8_STAMP();
        if (!has_next) break;
#pragma unroll
        for (int a = 0; a < 2; ++a)
#pragma unroll
            for (int b = 0; b < 2; ++b)
#pragma unroll
                for (int m = 0; m < 4; ++m)
#pragma unroll
                    for (int n = 0; n < 2; ++n) acc[a][b][m][n] = (f32x4){0.f, 0.f, 0.f, 0.f};
        cur = nxt; cA = nA; cB = nB; ++ui;
    }
    PG8_WAIT_V(0);
    if (wr == 0) PG8_BAR;
    PG8_BAR;
    if constexpr (Epi::AFTER_DRAIN) { E.fused(acc, cur, wr, wc, fr, fq, lds, wid, lane); S.done(cur); }
    PG8_STAMP();
    if (STAMP && wid == 0) { stamps[lane] = lane < nts ? (((unsigned long long)(unsigned)ts_hi << 32) | (unsigned)ts_lo) : 0ull;
        if (lane == 62) stamps[62] = rt_entry; if (lane == 63) stamps[63] = (unsigned long long)wall_clock64(); }
#undef PG8_STAMP
#undef PG8_SA
#undef PG8_SB
#undef PG8_STAGE
#undef PG8_LDA
#undef PG8_LDB
#undef PG8_MMA
#undef PG8_WAIT_V
#undef PG8_WAIT_L
#undef PG8_BAR
#undef PG8_SCHED
}
}

namespace mk {
using pg8::bf16_t; using pg8::bf16x8; using pg8::f32x4; using pg8::u32x4; using pg8::Unit; using pg8::Gemm; using pg8::StaticOrder; using pg8::cvt_pk_bf16;
typedef short s16x4 __attribute__((ext_vector_type(4)));
typedef float f32x16 __attribute__((ext_vector_type(16)));
#define LAS __attribute__((address_space(3)))

#define XB_TMO      128
#define XB_XCNT(j)  (256  + 64 * (j))
#define XB_XSUB(j)  (1280 + 64 * (j))
#define XB_XGEN(j)  (2304 + 64 * (j))
#define XB_TOP      3328
#define XB_TOPGEN   3392
#define XCD_BAR_WORDS 3456
#define XB_SPIN_CAP (1u << 18)

__device__ __forceinline__ unsigned xb_ld(unsigned* p)              { return __hip_atomic_load(p, __ATOMIC_RELAXED, __HIP_MEMORY_SCOPE_AGENT); }
__device__ __forceinline__ unsigned xb_add(unsigned* p, unsigned v) { return __hip_atomic_fetch_add(p, v, __ATOMIC_RELAXED, __HIP_MEMORY_SCOPE_AGENT); }
__device__ __forceinline__ unsigned xb_xcc_id() { return (unsigned)__builtin_amdgcn_s_getreg((3 << 11) | 20) & 0xFu; }
#define XB_SPIN(cond, bar) do { unsigned _sp = 0; while (cond) { __builtin_amdgcn_s_sleep(1); \
    if ((++_sp & 255u) == 0u) { if (xb_ld(&(bar)[XB_TMO])) break; if (_sp > XB_SPIN_CAP) { atomicAdd(&(bar)[XB_TMO], 1u); break; } } } } while (0)

struct XcdBarrier {
    unsigned* bar; unsigned x;
    volatile LAS unsigned* st;
};

__device__ __forceinline__ XcdBarrier xcd_barrier_post(unsigned* bar, volatile LAS unsigned* st) {
    XcdBarrier b; b.bar = bar; b.x = xb_xcc_id(); b.st = st;
    if (threadIdx.x == 0) (void)xb_add(&bar[XB_XCNT(b.x)], 1u);
    return b;
}
__device__ __forceinline__ void xcd_barrier_complete(unsigned* bar, unsigned x, unsigned& nloc, unsigned& nx) {
    const unsigned G = gridDim.x * gridDim.y * gridDim.z;
    unsigned sum, cnt, mine, sp = 0u;
    for (;;) {
        sum = 0u; cnt = 0u; mine = 0u;
#pragma unroll
        for (unsigned j = 0; j < 16; ++j) { const unsigned c = xb_ld(&bar[XB_XCNT(j)]); sum += c; cnt += (c > 0u) ? 1u : 0u; mine = (j == x) ? c : mine; }
        if (sum == G) break;
        __builtin_amdgcn_s_sleep(1);
        if ((++sp & 255u) == 0u) { if (xb_ld(&bar[XB_TMO])) break; if (sp > XB_SPIN_CAP) { atomicAdd(&bar[XB_TMO], 1u); break; } }
    }
    nloc = mine > 0u ? mine : 1u; nx = cnt > 0u ? cnt : 1u;
}

__device__ __forceinline__ void xcd_barrier(const XcdBarrier& b) {
    asm volatile("s_waitcnt vmcnt(0)" ::: "memory");
    __syncthreads();
    if (threadIdx.x == 0) {
        unsigned* bar = b.bar;
        __builtin_amdgcn_s_waitcnt(0);
        unsigned nloc = b.st[0], nx = b.st[1];
        if (nloc == 0u) { xcd_barrier_complete(bar, b.x, nloc, nx); b.st[0] = nloc; b.st[1] = nx; }
        const unsigned old = xb_add(&bar[XB_XSUB(b.x)], 1u);
        const unsigned gen = old / nloc;
        if (old + 1u == (gen + 1u) * nloc) {
            __builtin_amdgcn_fence(__ATOMIC_RELEASE, "agent");
            asm volatile("s_waitcnt vmcnt(0)" ::: "memory");
            const unsigned og = xb_add(&bar[XB_TOP], 1u);
            const unsigned tg = og / nx;
            if (og + 1u == (tg + 1u) * nx) xb_add(&bar[XB_TOPGEN], 1u);
            else XB_SPIN(xb_ld(&bar[XB_TOPGEN]) == tg, bar);
            __builtin_amdgcn_fence(__ATOMIC_ACQUIRE, "agent");
            xb_add(&bar[XB_XGEN(b.x)], 1u);
            asm volatile("s_waitcnt vmcnt(0)" ::: "memory");
        } else {
            XB_SPIN(xb_ld(&bar[XB_XGEN(b.x)]) == gen, bar);
            __builtin_amdgcn_fence(__ATOMIC_ACQUIRE, "agent");
            asm volatile("s_waitcnt vmcnt(0)" ::: "memory");
        }
    }
    __syncthreads();
}


constexpr int SEQ = 4096, DM = 1024, DI = 2048, GSEQ = 8, MR = GSEQ * SEQ, NROUND = 3;
constexpr size_t LDS_BYTES = 136 * 1024;
constexpr size_t OFF_WIN_DA = 0, OFF_WOUT_DA = OFF_WIN_DA + (size_t)8192 * 1024 * 2, OFF_WIN_RET = OFF_WOUT_DA + (size_t)1024 * 2048 * 2,
                 OFF_WOUT_RET = OFF_WIN_RET + (size_t)6144 * 1024 * 2, OFF_TAB = OFF_WOUT_RET + (size_t)1024 * 2048 * 2,
                 OFF_H = OFF_TAB + (size_t)4 * 4096 * 64 * 4, OFF_BIG = OFF_H + (size_t)MR * DM * 2;
constexpr size_t SZ_2048 = (size_t)MR * 2048 * 2, SZ_1024 = (size_t)MR * 1024 * 2;
constexpr size_t OFF_D0 = OFF_BIG + (size_t)5 * ((size_t)MR * 2048 * 2) + 1048576, OFF_D1 = OFF_D0 + (size_t)3 * MR * DM * 2, OFF_BAR = OFF_D1 + (size_t)MR * DM * 2;
constexpr size_t OFF_RQ = OFF_BIG, OFF_RK = OFF_RQ + SZ_1024, OFF_RV = OFF_RK + SZ_1024, OFF_RG = OFF_RV + SZ_2048, OFF_SF = OFF_RG + SZ_2048, OFF_SB = OFF_SF + SZ_2048;

struct Params {
    const float* x_prompt; const float* x_sample; const float* norm_g; const float* da_w_in; const float* lq1; const float* lk1; const float* lq2; const float* lk2;
    const float* da_subln_g; const float* da_w_out; const float* ret_w_in; const float* ret_decay_fwd; const float* ret_decay_bwd; const float* ret_subln_g;
    const float* ret_w_out; const float* final_norm_g; float* out; unsigned char* ws;
};

__device__ __forceinline__ unsigned short f2bf(float f) { unsigned u = __float_as_uint(f); u += 0x7FFFu + ((u >> 16) & 1u); return (unsigned short)(u >> 16); }
__device__ __forceinline__ float bflo(unsigned w) { return __uint_as_float(w << 16); }
__device__ __forceinline__ float bfhi(unsigned w) { return __uint_as_float(w & 0xffff0000u); }
__device__ __forceinline__ bf16x8 scale8(bf16x8 x, float f) {
    u32x4 w = *reinterpret_cast<u32x4*>(&x); u32x4 r;
    r.x = cvt_pk_bf16(bflo(w.x) * f, bfhi(w.x) * f); r.y = cvt_pk_bf16(bflo(w.y) * f, bfhi(w.y) * f);
    r.z = cvt_pk_bf16(bflo(w.z) * f, bfhi(w.z) * f); r.w = cvt_pk_bf16(bflo(w.w) * f, bfhi(w.w) * f);
    return *reinterpret_cast<bf16x8*>(&r);
}
#define MK_BAR() do { asm volatile("" ::: "memory"); __builtin_amdgcn_s_barrier(); asm volatile("" ::: "memory"); } while (0)
#define SBAR() __builtin_amdgcn_sched_barrier(0)
#define KSWZ(row, colB) ((row) * 256 + ((colB) ^ (((row) & 7) << 4)))
__device__ __forceinline__ int crow(int r, int hi) { return (r & 3) + 8 * (r >> 2) + 4 * hi; }
template <int NCG> __device__ __forceinline__ int v_st(int k, int c) { const int kk = (k & ~0xC) | ((k & 4) << 1) | ((k & 8) >> 1); return ((kk >> 3) * NCG + (c >> 5)) * 512 + ((kk & 7) * 32 + (c & 31)) * 2; }
__device__ __forceinline__ int v_rd_base(int lane) { return ((lane & 3) << 3) | (((lane >> 2) & 3) << 6) | (((lane >> 4) & 1) << 5) | (((lane >> 5) & 1) << 8); }
template <int OFF> __device__ __forceinline__ s16x4 tr_read(unsigned vb) {
    s16x4 r; asm volatile("ds_read_b64_tr_b16 %0, %1 offset:%2" : "=&v"(r) : "v"(vb), "i"(OFF) : "memory"); return r;
}
#define PKLH(L, H) (bf16x8){L[0], L[1], L[2], L[3], H[0], H[1], H[2], H[3]}
#define PK4(P, BASE, OUT) do { unsigned a0 = cvt_pk_bf16(P[BASE + 0], P[BASE + 1]), a1 = cvt_pk_bf16(P[BASE + 2], P[BASE + 3]);   \
    unsigned b0 = cvt_pk_bf16(P[BASE + 4], P[BASE + 5]), b1 = cvt_pk_bf16(P[BASE + 6], P[BASE + 7]);                              \
    auto r0 = __builtin_amdgcn_permlane32_swap(a0, b0, false, false); auto r1 = __builtin_amdgcn_permlane32_swap(a1, b1, false, false); \
    u32x4 w_ = {r0[0], r1[0], r0[1], r1[1]}; OUT = *reinterpret_cast<bf16x8*>(&w_); } while (0)

__device__ __forceinline__ void transpose_tile(const float* __restrict__ W, bf16_t* __restrict__ Wt, int K, int N, bool permDA, int tile, LAS float* t) {
    const int ntn = N / 64, kt = tile / ntn, nt = tile % ntn, k0 = kt * 64, n0 = nt * 64, tid = mk_opaque_tid();
#pragma unroll
    for (int i = 0; i < 8; ++i) { const int k = i * 8 + (tid >> 6), n = tid & 63; t[k * 65 + n] = W[(size_t)(k0 + k) * N + n0 + n]; }
    __syncthreads();
#pragma unroll
    for (int i = 0; i < 8; ++i) { const int n = i * 8 + (tid >> 6), k = tid & 63; const int ns = n0 + n; int nd = ns;
        if (permDA && ns < 4096) { const int d = ns & 127; nd = (ns & ~127) + (d < 64 ? 2 * d : 2 * (d - 64) + 1); }
        Wt[(size_t)nd * K + k0 + k] = f2bf(t[k * 65 + n]); }
    __syncthreads();
}
__device__ __forceinline__ void prep_phase(const Params& P, LAS unsigned char* lds) {
    LAS float* t = (LAS float*)lds;
    bf16_t* w0 = (bf16_t*)(P.ws + OFF_WIN_DA); bf16_t* w1 = (bf16_t*)(P.ws + OFF_WOUT_DA); bf16_t* w2 = (bf16_t*)(P.ws + OFF_WIN_RET); bf16_t* w3 = (bf16_t*)(P.ws + OFF_WOUT_RET);
    constexpr int T0 = 16 * 128, T1 = 32 * 16, T2 = 16 * 96, T3 = 32 * 16;
    for (int i = blockIdx.x; i < T0 + T1 + T2 + T3; i += gridDim.x) {
        if (i < T0) transpose_tile(P.da_w_in, w0, 1024, 8192, true, i, t);
        else if (i < T0 + T1) transpose_tile(P.da_w_out, w1, 2048, 1024, false, i - T0, t);
        else if (i < T0 + T1 + T2) transpose_tile(P.ret_w_in, w2, 1024, 6144, false, i - T0 - T1, t);
        else transpose_tile(P.ret_w_out, w3, 2048, 1024, false, i - T0 - T1 - T2, t);
    }
    float* tab = (float*)(P.ws + OFF_TAB);
    for (int idx = blockIdx.x * 512 + threadIdx.x; idx < 2 * 4096 * 64; idx += gridDim.x * 512) {
        const int which = idx >> 18, e = idx & 262143, pos = e >> 6, i = e & 63;
        const double ex = which ? (double)i / 63.0 : (double)i / 64.0;
        const float inv = (float)exp(-ex * 9.210340371976184);
        const float ang = (float)pos * inv;
        double rev = (double)ang * 0.15915494309189535; rev -= rint(rev);
        const float rr = (float)(rev * 6.283185307179586);
        tab[(size_t)(which * 2) * 262144 + e] = __cosf(rr); tab[(size_t)(which * 2 + 1) * 262144 + e] = __sinf(rr);
    }
}

__device__ __forceinline__ void norm_to_bf16(const float* __restrict__ X, const float* __restrict__ g, bf16_t* __restrict__ H, int rows) {
    const int tid_ = mk_opaque_tid(), lane = tid_ & 63, gw = blockIdx.x * 8 + (tid_ >> 6), nw = gridDim.x * 8;
    f32x4 gv[4];
#pragma unroll
    for (int j = 0; j < 4; ++j) gv[j] = *(const f32x4*)(g + j * 256 + lane * 4);
    for (int r0 = gw; r0 < rows; r0 += 4 * nw) {
        f32x4 v[4][4];
#pragma unroll
        for (int q = 0; q < 4; ++q)
#pragma unroll
            for (int j = 0; j < 4; ++j) v[q][j] = __builtin_nontemporal_load((const f32x4*)(X + (size_t)(r0 + q * nw) * DM + j * 256 + lane * 4));
#pragma unroll
        for (int q = 0; q < 4; ++q) { float ss = 0.f;
#pragma unroll
            for (int j = 0; j < 4; ++j) ss += v[q][j][0] * v[q][j][0] + v[q][j][1] * v[q][j][1] + v[q][j][2] * v[q][j][2] + v[q][j][3] * v[q][j][3];
#pragma unroll
            for (int o = 32; o >= 1; o >>= 1) ss += __shfl_xor(ss, o);
            const float rs = rsqrtf(ss * (1.0f / DM) + 1e-6f);
#pragma unroll
            for (int j = 0; j < 4; ++j) { uint2 w; w.x = cvt_pk_bf16(v[q][j][0] * rs * gv[j][0], v[q][j][1] * rs * gv[j][1]); w.y = cvt_pk_bf16(v[q][j][2] * rs * gv[j][2], v[q][j][3] * rs * gv[j][3]);
                *(uint2*)(H + (size_t)(r0 + q * nw) * DM + j * 256 + lane * 4) = w; } }
    }
}
__device__ __forceinline__ void norm_inplace_f32(float* __restrict__ X, const float* __restrict__ g, int rows) {
    const int tid_ = mk_opaque_tid(), lane = tid_ & 63, gw = blockIdx.x * 8 + (tid_ >> 6), nw = gridDim.x * 8;
    f32x4 gv[4];
#pragma unroll
    for (int j = 0; j < 4; ++j) gv[j] = *(const f32x4*)(g + j * 256 + lane * 4);
    for (int r0 = gw; r0 < rows; r0 += 4 * nw) {
        f32x4 v[4][4];
#pragma unroll
        for (int q = 0; q < 4; ++q)
#pragma unroll
            for (int j = 0; j < 4; ++j) v[q][j] = *(const f32x4*)(X + (size_t)(r0 + q * nw) * DM + j * 256 + lane * 4);
#pragma unroll
        for (int q = 0; q < 4; ++q) { float ss = 0.f;
#pragma unroll
            for (int j = 0; j < 4; ++j) ss += v[q][j][0] * v[q][j][0] + v[q][j][1] * v[q][j][1] + v[q][j][2] * v[q][j][2] + v[q][j][3] * v[q][j][3];
#pragma unroll
            for (int o = 32; o >= 1; o >>= 1) ss += __shfl_xor(ss, o);
            const float rs = rsqrtf(ss * (1.0f / DM) + 1e-6f);
#pragma unroll
            for (int j = 0; j < 4; ++j) { f32x4 y = {v[q][j][0] * rs * gv[j][0], v[q][j][1] * rs * gv[j][1], v[q][j][2] * rs * gv[j][2], v[q][j][3] * rs * gv[j][3]}; *(f32x4*)(X + (size_t)(r0 + q * nw) * DM + j * 256 + lane * 4) = y; } }
    }
}

__device__ __forceinline__ void comb_norm_to_bf16(const float* __restrict__ Xin, const bf16_t* __restrict__ D, float* __restrict__ Xout, const float* __restrict__ g, bf16_t* __restrict__ H, int rows) {
    const int tid_ = mk_opaque_tid(), lane = tid_ & 63, gw = blockIdx.x * 8 + (tid_ >> 6), nw = gridDim.x * 8;
    f32x4 gv[4];
#pragma unroll
    for (int j = 0; j < 4; ++j) gv[j] = *(const f32x4*)(g + j * 256 + lane * 4);
    for (int r0 = gw; r0 < rows; r0 += 4 * nw) {
        f32x4 v[4][4]; uint2 d[4][4];
#pragma unroll
        for (int q = 0; q < 4; ++q)
#pragma unroll
            for (int j = 0; j < 4; ++j) { const size_t o = (size_t)(r0 + q * nw) * DM + j * 256 + lane * 4; v[q][j] = __builtin_nontemporal_load((const f32x4*)(Xin + o)); d[q][j] = *(const uint2*)(D + o); }
#pragma unroll
        for (int q = 0; q < 4; ++q) { float ss = 0.f;
#pragma unroll
            for (int j = 0; j < 4; ++j) { v[q][j][0] += bflo(d[q][j].x); v[q][j][1] += bfhi(d[q][j].x); v[q][j][2] += bflo(d[q][j].y); v[q][j][3] += bfhi(d[q][j].y);
                ss += v[q][j][0] * v[q][j][0] + v[q][j][1] * v[q][j][1] + v[q][j][2] * v[q][j][2] + v[q][j][3] * v[q][j][3]; }
#pragma unroll
            for (int o = 32; o >= 1; o >>= 1) ss += __shfl_xor(ss, o);
            const float rs = rsqrtf(ss * (1.0f / DM) + 1e-6f);
#pragma unroll
            for (int j = 0; j < 4; ++j) { const size_t o = (size_t)(r0 + q * nw) * DM + j * 256 + lane * 4; if (Xout) *(f32x4*)(Xout + o) = v[q][j];
                uint2 w; w.x = cvt_pk_bf16(v[q][j][0] * rs * gv[j][0], v[q][j][1] * rs * gv[j][1]); w.y = cvt_pk_bf16(v[q][j][2] * rs * gv[j][2], v[q][j][3] * rs * gv[j][3]);
                *(uint2*)(H + o) = w; } }
    }
}
__device__ __forceinline__ void comb_norm_inplace_f32(float* __restrict__ X, const bf16_t* __restrict__ D, const float* __restrict__ g, int rows) {
    const int tid_ = mk_opaque_tid(), lane = tid_ & 63, gw = blockIdx.x * 8 + (tid_ >> 6), nw = gridDim.x * 8;
    f32x4 gv[4];
#pragma unroll
    for (int j = 0; j < 4; ++j) gv[j] = *(const f32x4*)(g + j * 256 + lane * 4);
    for (int r0 = gw; r0 < rows; r0 += 4 * nw) {
        f32x4 v[4][4]; uint2 d[4][4];
#pragma unroll
        for (int q = 0; q < 4; ++q)
#pragma unroll
            for (int j = 0; j < 4; ++j) { const size_t o = (size_t)(r0 + q * nw) * DM + j * 256 + lane * 4; v[q][j] = *(const f32x4*)(X + o); d[q][j] = *(const uint2*)(D + o); }
#pragma unroll
        for (int q = 0; q < 4; ++q) { float ss = 0.f;
#pragma unroll
            for (int j = 0; j < 4; ++j) { v[q][j][0] += bflo(d[q][j].x); v[q][j][1] += bfhi(d[q][j].x); v[q][j][2] += bflo(d[q][j].y); v[q][j][3] += bfhi(d[q][j].y);
                ss += v[q][j][0] * v[q][j][0] + v[q][j][1] * v[q][j][1] + v[q][j][2] * v[q][j][2] + v[q][j][3] * v[q][j][3]; }
#pragma unroll
            for (int o = 32; o >= 1; o >>= 1) ss += __shfl_xor(ss, o);
            const float rs = rsqrtf(ss * (1.0f / DM) + 1e-6f);
#pragma unroll
            for (int j = 0; j < 4; ++j) { f32x4 y = {v[q][j][0] * rs * gv[j][0], v[q][j][1] * rs * gv[j][1], v[q][j][2] * rs * gv[j][2], v[q][j][3] * rs * gv[j][3]}; *(f32x4*)(X + (size_t)(r0 + q * nw) * DM + j * 256 + lane * 4) = y; } }
    }
}

__device__ __forceinline__ void comb2_norm_out(const float* __restrict__ Xin, const bf16_t* __restrict__ Da, const bf16_t* __restrict__ Db, const float* __restrict__ g, float* __restrict__ Out, int rows) {
    const int tid_ = mk_opaque_tid(), lane = tid_ & 63, gw = blockIdx.x * 8 + (tid_ >> 6), nw = gridDim.x * 8;
    f32x4 gv[4];
#pragma unroll
    for (int j = 0; j < 4; ++j) gv[j] = *(const f32x4*)(g + j * 256 + lane * 4);
    for (int r0 = gw; r0 < rows; r0 += 4 * nw) {
        f32x4 v[4][4]; uint2 da[4][4], db[4][4];
#pragma unroll
        for (int q = 0; q < 4; ++q)
#pragma unroll
            for (int j = 0; j < 4; ++j) { const size_t o = (size_t)(r0 + q * nw) * DM + j * 256 + lane * 4; v[q][j] = __builtin_nontemporal_load((const f32x4*)(Xin + o)); { typedef unsigned u32x2v_ __attribute__((ext_vector_type(2))); const u32x2v_ ta = __builtin_nontemporal_load((const u32x2v_*)(Da + o)), tb = __builtin_nontemporal_load((const u32x2v_*)(Db + o)); da[q][j].x = ta[0]; da[q][j].y = ta[1]; db[q][j].x = tb[0]; db[q][j].y = tb[1]; } }
#pragma unroll
        for (int q = 0; q < 4; ++q) { float ss = 0.f;
#pragma unroll
            for (int j = 0; j < 4; ++j) { v[q][j][0] += bflo(da[q][j].x) + bflo(db[q][j].x); v[q][j][1] += bfhi(da[q][j].x) + bfhi(db[q][j].x); v[q][j][2] += bflo(da[q][j].y) + bflo(db[q][j].y); v[q][j][3] += bfhi(da[q][j].y) + bfhi(db[q][j].y);
                ss += v[q][j][0] * v[q][j][0] + v[q][j][1] * v[q][j][1] + v[q][j][2] * v[q][j][2] + v[q][j][3] * v[q][j][3]; }
#pragma unroll
            for (int o = 32; o >= 1; o >>= 1) ss += __shfl_xor(ss, o);
            const float rs = rsqrtf(ss * (1.0f / DM) + 1e-6f);
#pragma unroll
            for (int j = 0; j < 4; ++j) { f32x4 y = {v[q][j][0] * rs * gv[j][0], v[q][j][1] * rs * gv[j][1], v[q][j][2] * rs * gv[j][2], v[q][j][3] * rs * gv[j][3]}; __builtin_nontemporal_store(y, (f32x4*)(Out + (size_t)(r0 + q * nw) * DM + j * 256 + lane * 4)); } }
    }
}

__device__ __forceinline__ u32x4 rot_pack(f32x4 v0, f32x4 v1, const float* tc, const float* ts, float sc) {
    const f32x4 c = *(const f32x4*)tc, s = *(const f32x4*)ts; u32x4 w;
    w.x = cvt_pk_bf16((v0[0] * c[0] - v0[1] * s[0]) * sc, (v0[1] * c[0] + v0[0] * s[0]) * sc);
    w.y = cvt_pk_bf16((v0[2] * c[1] - v0[3] * s[1]) * sc, (v0[3] * c[1] + v0[2] * s[1]) * sc);
    w.z = cvt_pk_bf16((v1[0] * c[2] - v1[1] * s[2]) * sc, (v1[1] * c[2] + v1[0] * s[2]) * sc);
    w.w = cvt_pk_bf16((v1[2] * c[3] - v1[3] * s[3]) * sc, (v1[3] * c[3] + v1[2] * s[3]) * sc);
    return w;
}
__device__ __forceinline__ u32x4 plain_pack(f32x4 v0, f32x4 v1) { u32x4 w; w.x = cvt_pk_bf16(v0[0], v0[1]); w.y = cvt_pk_bf16(v0[2], v0[3]); w.z = cvt_pk_bf16(v1[0], v1[1]); w.w = cvt_pk_bf16(v1[2], v1[3]); return w; }

struct EpiDA {
    static constexpr bool PERM = true, AFTER_DRAIN = false;
    bf16_t* big; const float* tcos; const float* tsin;
    __device__ __forceinline__ void operator()(const f32x4 (&acc)[2][2][4][2], const Unit& u, int wr, int wc, int fr, int fq) const {
        const int region = u.pn >> 3; bf16_t* base = big + (size_t)region * ((size_t)MR * 2048);
        const int colr0 = (u.pn & 7) * 256 + wc * 32 + 8 * fq, row0 = u.pm * 256 + wr * 64 + fr;
        if (region < 2) {
            const int i0 = (colr0 & 127) >> 1; const float sc = region == 0 ? 0.08838834764831845f : 1.0f;
            f32x4 cs[8], sn[8];
#pragma unroll
            for (int q = 0; q < 8; ++q) { const int pos = (row0 + (q >> 2) * 128 + (q & 3) * 16) & (SEQ - 1); cs[q] = *(const f32x4*)(tcos + pos * 64 + i0); sn[q] = *(const f32x4*)(tsin + pos * 64 + i0); }
            asm volatile("" ::: "memory");
#pragma unroll
            for (int q = 0; q < 8; ++q) { const int ai = q >> 2, m = q & 3, row = row0 + ai * 128 + m * 16; const f32x4 c = cs[q], s = sn[q];
#pragma unroll
                for (int bj = 0; bj < 2; ++bj) { const f32x4 v0 = acc[ai][bj][m][0], v1 = acc[ai][bj][m][1]; u32x4 w;
                    w.x = cvt_pk_bf16((v0[0] * c[0] - v0[1] * s[0]) * sc, (v0[1] * c[0] + v0[0] * s[0]) * sc);
                    w.y = cvt_pk_bf16((v0[2] * c[1] - v0[3] * s[1]) * sc, (v0[3] * c[1] + v0[2] * s[1]) * sc);
                    w.z = cvt_pk_bf16((v1[0] * c[2] - v1[1] * s[2]) * sc, (v1[1] * c[2] + v1[0] * s[2]) * sc);
                    w.w = cvt_pk_bf16((v1[2] * c[3] - v1[3] * s[3]) * sc, (v1[3] * c[3] + v1[2] * s[3]) * sc);
                    *(u32x4*)(base + (size_t)row * 2048 + colr0 + bj * 128) = w; } }
        } else {
#pragma unroll
            for (int ai = 0; ai < 2; ++ai)
#pragma unroll
                for (int m = 0; m < 4; ++m) { const int row = row0 + ai * 128 + m * 16;
#pragma unroll
                    for (int bj = 0; bj < 2; ++bj) *(u32x4*)(base + (size_t)row * 2048 + colr0 + bj * 128) = plain_pack(acc[ai][bj][m][0], acc[ai][bj][m][1]); }
        }
    }
};
struct EpiRET {
    static constexpr bool PERM = true, AFTER_DRAIN = false;
    bf16_t* rq; bf16_t* rk; bf16_t* rv; bf16_t* rg; const float* tcos; const float* tsin;
    __device__ __forceinline__ void operator()(const f32x4 (&acc)[2][2][4][2], const Unit& u, int wr, int wc, int fr, int fq) const {
        const bool isrot = u.pn < 8; bf16_t* base; int ld, colt;
        if (u.pn < 4) { base = rq; ld = 1024; colt = u.pn * 256; } else if (u.pn < 8) { base = rk; ld = 1024; colt = (u.pn - 4) * 256; }
        else if (u.pn < 16) { base = rv; ld = 2048; colt = (u.pn - 8) * 256; } else { base = rg; ld = 2048; colt = (u.pn - 16) * 256; }
        const int colr0 = colt + wc * 32 + 8 * fq, row0 = u.pm * 256 + wr * 64 + fr;
        if (isrot) {
            const int i0 = (colr0 & 127) >> 1; const float sc = u.pn >= 4 ? 0.08838834764831845f : 1.0f;
            f32x4 cs[8], sn[8];
#pragma unroll
            for (int q = 0; q < 8; ++q) { const int pos = (row0 + (q >> 2) * 128 + (q & 3) * 16) & (SEQ - 1); cs[q] = *(const f32x4*)(tcos + pos * 64 + i0); sn[q] = *(const f32x4*)(tsin + pos * 64 + i0); }
            asm volatile("" ::: "memory");
#pragma unroll
            for (int q = 0; q < 8; ++q) { const int ai = q >> 2, m = q & 3, row = row0 + ai * 128 + m * 16; const f32x4 c = cs[q], s = sn[q];
#pragma unroll
                for (int bj = 0; bj < 2; ++bj) { const f32x4 v0 = acc[ai][bj][m][0], v1 = acc[ai][bj][m][1]; u32x4 w;
                    w.x = cvt_pk_bf16((v0[0] * c[0] - v0[1] * s[0]) * sc, (v0[1] * c[0] + v0[0] * s[0]) * sc);
                    w.y = cvt_pk_bf16((v0[2] * c[1] - v0[3] * s[1]) * sc, (v0[3] * c[1] + v0[2] * s[1]) * sc);
                    w.z = cvt_pk_bf16((v1[0] * c[2] - v1[1] * s[2]) * sc, (v1[1] * c[2] + v1[0] * s[2]) * sc);
                    w.w = cvt_pk_bf16((v1[2] * c[3] - v1[3] * s[3]) * sc, (v1[3] * c[3] + v1[2] * s[3]) * sc);
                    *(u32x4*)(base + (size_t)row * ld + colr0 + bj * 128) = w; } }
        } else {
#pragma unroll
            for (int ai = 0; ai < 2; ++ai)
#pragma unroll
                for (int m = 0; m < 4; ++m) { const int row = row0 + ai * 128 + m * 16;
#pragma unroll
                    for (int bj = 0; bj < 2; ++bj) *(u32x4*)(base + (size_t)row * ld + colr0 + bj * 128) = plain_pack(acc[ai][bj][m][0], acc[ai][bj][m][1]); }
        }
    }
};
struct EpiRes {
    static constexpr bool PERM = false, AFTER_DRAIN = false;
    float* out; const float* res;
    __device__ __forceinline__ void operator()(const f32x4 (&acc)[2][2][4][2], const Unit& u, int wr, int wc, int fr, int fq) const {
        const int row0 = u.pm * 256 + wr * 64 + fr, col0 = u.pn * 256 + wc * 32 + 4 * fq;
#pragma unroll
        for (int ai = 0; ai < 2; ++ai) {
            f32x4 r[4][2][2];
#pragma unroll
            for (int m = 0; m < 4; ++m)
#pragma unroll
                for (int bj = 0; bj < 2; ++bj)
#pragma unroll
                    for (int n = 0; n < 2; ++n) r[m][bj][n] = *(const f32x4*)(res + (size_t)(row0 + ai * 128 + m * 16) * DM + col0 + bj * 128 + n * 16);
            asm volatile("" ::: "memory");
#pragma unroll
            for (int m = 0; m < 4; ++m)
#pragma unroll
                for (int bj = 0; bj < 2; ++bj)
#pragma unroll
                    for (int n = 0; n < 2; ++n) *(f32x4*)(out + (size_t)(row0 + ai * 128 + m * 16) * DM + col0 + bj * 128 + n * 16) = acc[ai][bj][m][n] + r[m][bj][n];
        }
    }
};
struct EpiDelta {
    static constexpr bool PERM = true, AFTER_DRAIN = false;
    bf16_t* D;
    __device__ __forceinline__ void operator()(const f32x4 (&acc)[2][2][4][2], const Unit& u, int wr, int wc, int fr, int fq) const {
        const int colr0 = u.pn * 256 + wc * 32 + 8 * fq, row0 = u.pm * 256 + wr * 64 + fr;
#pragma unroll
        for (int ai = 0; ai < 2; ++ai)
#pragma unroll
            for (int m = 0; m < 4; ++m) { const int row = row0 + ai * 128 + m * 16;
#pragma unroll
                for (int bj = 0; bj < 2; ++bj) *(u32x4*)(D + (size_t)row * DM + colr0 + bj * 128) = plain_pack(acc[ai][bj][m][0], acc[ai][bj][m][1]); }
    }
};
template <class Epi> __device__ __forceinline__ void run_gemm(LAS unsigned char* lds, const bf16_t* A, const bf16_t* Bt, int M, int N, int K, const Epi& E) {
    Gemm g; g.A = A; g.Bt = Bt; g.M = M; g.N = N; g.K = K;
    StaticOrder S; S.init(M, N, (int)gridDim.x, (int)blockIdx.x);
    pg8::gemm_phase<Epi, StaticOrder, false>(lds, g, S, E, nullptr);
}

__device__ __forceinline__ void subln_gate_store(LAS unsigned char* lds, const float* __restrict__ g, float oscale, const bf16_t* __restrict__ gate, bf16_t* __restrict__ dst, int ld) {
    const int tid_ = mk_opaque_tid(), wid = tid_ >> 6, lane = tid_ & 63, cc = lane & 31;
    f32x4 g0 = *(const f32x4*)(g + cc * 8), g1 = *(const f32x4*)(g + cc * 8 + 4);
    u32x4 gt[8];
#pragma unroll
    for (int j = 0; j < 8; ++j) gt[j] = *(const u32x4*)(gate + (size_t)(16 * wid + 2 * j + (lane >> 5)) * ld + cc * 8);
    asm volatile("" ::: "memory");
#pragma unroll
    for (int j = 0; j < 8; ++j) {
        const int row = 16 * wid + 2 * j + (lane >> 5);
        const f32x4 a = *(const LAS f32x4*)(lds + (row * 256 + cc * 8) * 4), b = *(const LAS f32x4*)(lds + (row * 256 + cc * 8 + 4) * 4);
        float ss = a[0] * a[0] + a[1] * a[1] + a[2] * a[2] + a[3] * a[3] + b[0] * b[0] + b[1] * b[1] + b[2] * b[2] + b[3] * b[3];
#pragma unroll
        for (int o = 16; o >= 1; o >>= 1) ss += __shfl_xor(ss, o);
        const float rs = rsqrtf(ss * (1.0f / 256.0f) + 1e-5f) * oscale;
        float gg[8] = {bflo(gt[j].x), bfhi(gt[j].x), bflo(gt[j].y), bfhi(gt[j].y), bflo(gt[j].z), bfhi(gt[j].z), bflo(gt[j].w), bfhi(gt[j].w)};
        float y[8] = {a[0] * g0[0], a[1] * g0[1], a[2] * g0[2], a[3] * g0[3], b[0] * g1[0], b[1] * g1[1], b[2] * g1[2], b[3] * g1[3]};
#pragma unroll
        for (int e2 = 0; e2 < 8; ++e2) { const float sg = gg[e2] * __builtin_amdgcn_rcpf(1.0f + __expf(-gg[e2])); y[e2] = y[e2] * rs * sg; }
        u32x4 w; w.x = cvt_pk_bf16(y[0], y[1]); w.y = cvt_pk_bf16(y[2], y[3]); w.z = cvt_pk_bf16(y[4], y[5]); w.w = cvt_pk_bf16(y[6], y[7]);
        *(u32x4*)(dst + (size_t)row * ld + cc * 8) = w;
    }
}

constexpr float LOG2E = 1.4426950408889634f, ATHR = 8.0f;
__device__ __forceinline__ void partialSM(f32x16& p0, f32x16& p1, float& m_reg, float& mn, float& alpha) {
    float pmax = p0[0];
#pragma unroll
    for (int r = 1; r < 16; ++r) pmax = fmaxf(pmax, p0[r]);
#pragma unroll
    for (int r = 0; r < 16; ++r) pmax = fmaxf(pmax, p1[r]);
    { auto rr = __builtin_amdgcn_permlane32_swap(__float_as_uint(pmax), __float_as_uint(pmax), false, false); pmax = fmaxf(__uint_as_float(rr[0]), __uint_as_float(rr[1])); }
    if (__builtin_expect(__all(pmax - m_reg <= ATHR), 1)) { mn = m_reg; alpha = 1.f; }
    else { mn = fmaxf(m_reg, pmax); alpha = __builtin_amdgcn_exp2f((m_reg - mn) * LOG2E); m_reg = mn; }
    const float mnC = -mn * LOG2E;
#pragma unroll
    for (int r = 0; r < 16; ++r) p0[r] = __builtin_amdgcn_exp2f(fmaf(p0[r], LOG2E, mnC));
#pragma unroll
    for (int r = 0; r < 16; ++r) p1[r] = __builtin_amdgcn_exp2f(fmaf(p1[r], LOG2E, mnC));
}
__device__ __forceinline__ void finishSM(f32x16& p0, f32x16& p1, float alpha, float& l_reg, bf16x8& pa0, bf16x8& pa1, bf16x8& pa2, bf16x8& pa3) {
    float ps = 0;
#pragma unroll
    for (int r = 0; r < 16; ++r) ps += p0[r];
#pragma unroll
    for (int r = 0; r < 16; ++r) ps += p1[r];
    { auto rr = __builtin_amdgcn_permlane32_swap(__float_as_uint(ps), __float_as_uint(ps), false, false); ps = __uint_as_float(rr[0]) + __uint_as_float(rr[1]); }
    l_reg = l_reg * alpha + ps;
    PK4(p0, 0, pa0); PK4(p0, 8, pa1); PK4(p1, 0, pa2); PK4(p1, 8, pa3);
}
template <int D0> __device__ __forceinline__ void pv_one(f32x16& od, unsigned vb, bf16x8 pa0, bf16x8 pa1, bf16x8 pa2, bf16x8 pa3) {
    const s16x4 l0 = tr_read<D0 * 512 + 0 * 8192>(vb), h0 = tr_read<D0 * 512 + 0 * 8192 + 4096>(vb), l1 = tr_read<D0 * 512 + 1 * 8192>(vb), h1 = tr_read<D0 * 512 + 1 * 8192 + 4096>(vb);
    const s16x4 l2 = tr_read<D0 * 512 + 2 * 8192>(vb), h2 = tr_read<D0 * 512 + 2 * 8192 + 4096>(vb), l3 = tr_read<D0 * 512 + 3 * 8192>(vb), h3 = tr_read<D0 * 512 + 3 * 8192 + 4096>(vb);
    asm volatile("s_waitcnt lgkmcnt(0)" ::: "memory"); SBAR();
    od = __builtin_amdgcn_mfma_f32_32x32x16_bf16(pa0, PKLH(l0, h0), od, 0, 0, 0);
    od = __builtin_amdgcn_mfma_f32_32x32x16_bf16(pa1, PKLH(l1, h1), od, 0, 0, 0);
    od = __builtin_amdgcn_mfma_f32_32x32x16_bf16(pa2, PKLH(l2, h2), od, 0, 0, 0);
    od = __builtin_amdgcn_mfma_f32_32x32x16_bf16(pa3, PKLH(l3, h3), od, 0, 0, 0);
}

#define SBV() __builtin_amdgcn_sched_barrier(0x2 | 0x4 | 0x400)
__device__ __forceinline__ void smA(f32x16& p0, f32x16& p1, float& m_reg, float& alpha) {
    float pmax = p0[0];
#pragma unroll
    for (int r = 1; r < 16; ++r) pmax = fmaxf(pmax, p0[r]);
#pragma unroll
    for (int r = 0; r < 16; ++r) pmax = fmaxf(pmax, p1[r]);
    { auto rr = __builtin_amdgcn_permlane32_swap(__float_as_uint(pmax), __float_as_uint(pmax), false, false); pmax = fmaxf(__uint_as_float(rr[0]), __uint_as_float(rr[1])); }
    float mn;
    if (__builtin_expect(__all(pmax - m_reg <= ATHR), 1)) { mn = m_reg; alpha = 1.f; }
    else { mn = fmaxf(m_reg, pmax); alpha = __builtin_amdgcn_exp2f((m_reg - mn) * LOG2E); m_reg = mn; }
    const float mnC = -mn * LOG2E;
#pragma unroll
    for (int r = 0; r < 16; ++r) p0[r] = __builtin_amdgcn_exp2f(fmaf(p0[r], LOG2E, mnC));
#pragma unroll
    for (int r = 0; r < 16; ++r) p1[r] = fmaf(p1[r], LOG2E, mnC);
}
template <int D0, int KS0> __device__ __forceinline__ void pv_half(f32x16& oa, f32x16& ob, unsigned vb, bf16x8 paX, bf16x8 paY) {
    const s16x4 l0 = tr_read<D0 * 512 + KS0 * 8192>(vb), h0 = tr_read<D0 * 512 + KS0 * 8192 + 4096>(vb), l1 = tr_read<D0 * 512 + (KS0 + 1) * 8192>(vb), h1 = tr_read<D0 * 512 + (KS0 + 1) * 8192 + 4096>(vb);
    const s16x4 m0 = tr_read<(D0 + 1) * 512 + KS0 * 8192>(vb), n0 = tr_read<(D0 + 1) * 512 + KS0 * 8192 + 4096>(vb), m1 = tr_read<(D0 + 1) * 512 + (KS0 + 1) * 8192>(vb), n1 = tr_read<(D0 + 1) * 512 + (KS0 + 1) * 8192 + 4096>(vb);
    asm volatile("s_waitcnt lgkmcnt(0)" ::: "memory"); SBV();
    oa = __builtin_amdgcn_mfma_f32_32x32x16_bf16(paX, PKLH(l0, h0), oa, 0, 0, 0);
    oa = __builtin_amdgcn_mfma_f32_32x32x16_bf16(paY, PKLH(l1, h1), oa, 0, 0, 0);
    ob = __builtin_amdgcn_mfma_f32_32x32x16_bf16(paX, PKLH(m0, n0), ob, 0, 0, 0);
    ob = __builtin_amdgcn_mfma_f32_32x32x16_bf16(paY, PKLH(m1, n1), ob, 0, 0, 0);
}
__device__ __forceinline__ void attn_phase(const Params& P, LAS unsigned char* lds) {
    constexpr int NT = SEQ / 64;
    for (int it = blockIdx.x; it < GSEQ * 8 * 32; it += gridDim.x) {
        const int tid = mk_opaque_tid(), wid = __builtin_amdgcn_readfirstlane(tid >> 6), lane = tid & 63, r32 = lane & 31, hi = lane >> 5;
        const int map = wid >> 2, wq = wid & 3;
        bf16_t* qbuf = (bf16_t*)(P.ws + OFF_BIG); const bf16_t* kbuf = qbuf + (size_t)MR * 2048; const bf16_t* vbuf = kbuf + (size_t)MR * 2048; const bf16_t* gbuf = vbuf + (size_t)MR * 2048;
        const unsigned lds0 = (unsigned)(size_t)lds;
        LAS float* li_l = (LAS float*)(lds + 131072 + wid * 256); LAS float* al_l = li_l + 32;
        const unsigned kL = (unsigned)((4 * wid + (lane >> 4)) * 2048 + (((lane & 15) ^ (4 * (wid & 1) + (lane >> 4))) * 8)) * 2u;
        const unsigned vL = (unsigned)((8 * ((lane >> 4) & 1) + 4 * (wid >> 2) + ((lane >> 2) & 3)) * 2048 + (2 * (wid & 3) + (lane >> 5)) * 32 + (lane & 3) * 8) * 2u;
        const int head = it & 7, qblk = (it >> 3) & 31, seq = it >> 8;
        const size_t tok0 = (size_t)seq * SEQ;
        const char* kb = (const char*)(kbuf + tok0 * 2048 + (2 * head) * 128);
        const char* vb = (const char*)(vbuf + tok0 * 2048 + head * 256);
#define AT_PIECE(i, sbase, ko_, vo_) do { \
        if ((i) == 0) __builtin_amdgcn_global_load_lds((const unsigned*)(kb + (ko_)), (LAS unsigned*)(sbase), 16, 0, 2); \
        if ((i) == 1) __builtin_amdgcn_global_load_lds((const unsigned*)(kb + ((ko_) + 32u * 4096u)), (LAS unsigned*)((sbase) + 8192), 16, 0, 2); \
        if ((i) == 2) __builtin_amdgcn_global_load_lds((const unsigned*)(kb + ((ko_) + 256u)), (LAS unsigned*)((sbase) + 16384), 16, 0, 2); \
        if ((i) == 3) __builtin_amdgcn_global_load_lds((const unsigned*)(kb + ((ko_) + 256u + 32u * 4096u)), (LAS unsigned*)((sbase) + 16384 + 8192), 16, 0, 2); \
        if ((i) == 4) __builtin_amdgcn_global_load_lds((const unsigned*)(vb + (vo_)), (LAS unsigned*)((sbase) + 32768), 16, 0, 2); \
        if ((i) == 5) __builtin_amdgcn_global_load_lds((const unsigned*)(vb + ((vo_) + 16u * 4096u)), (LAS unsigned*)((sbase) + 32768 + 8192), 16, 0, 2); \
        if ((i) == 6) __builtin_amdgcn_global_load_lds((const unsigned*)(vb + ((vo_) + 32u * 4096u)), (LAS unsigned*)((sbase) + 32768 + 16384), 16, 0, 2); \
        if ((i) == 7) __builtin_amdgcn_global_load_lds((const unsigned*)(vb + ((vo_) + 48u * 4096u)), (LAS unsigned*)((sbase) + 32768 + 24576), 16, 0, 2); } while (0)
#define AT_ISSUE(st, k0) do { LAS unsigned char* s_ = lds + (st) * 65536 + wid * 1024; const unsigned ko_ = kL + (unsigned)(k0) * 4096u, vo_ = vL + (unsigned)(k0) * 4096u; \
        AT_PIECE(0, s_, ko_, vo_); AT_PIECE(1, s_, ko_, vo_); AT_PIECE(2, s_, ko_, vo_); AT_PIECE(3, s_, ko_, vo_); AT_PIECE(4, s_, ko_, vo_); AT_PIECE(5, s_, ko_, vo_); AT_PIECE(6, s_, ko_, vo_); AT_PIECE(7, s_, ko_, vo_); } while (0)
        const size_t qrow0 = tok0 + qblk * 128;
        bf16x8 qr[8];
        { const bf16_t* qp = qbuf + (qrow0 + wq * 32 + r32) * 2048 + (2 * head + map) * 128 + hi * 8;
#pragma unroll
          for (int d0 = 0; d0 < 8; ++d0) qr[d0] = *(const bf16x8*)(qp + d0 * 16); }
        AT_ISSUE(0, 0);
        asm volatile("s_waitcnt vmcnt(0)" ::: "memory"); MK_BAR();
        float m_reg = -1e30f, l_reg = 0.f; f32x16 o[8];
#pragma unroll
        for (int d = 0; d < 8; ++d) o[d] = f32x16{};
        for (int j = 0; j < NT; ++j) {
            const unsigned st = (unsigned)(j & 1) * 65536u;
            f32x16 p0 = f32x16{}, p1 = f32x16{};
            { const LAS unsigned char* Ks = lds + st + map * 16384;
              const bool more = j + 1 < NT;
              LAS unsigned char* sn_ = lds + (65536u - st) + wid * 1024; const unsigned kon_ = kL + (unsigned)(j + 1) * (64u * 4096u), von_ = vL + (unsigned)(j + 1) * (64u * 4096u);
#pragma unroll
              for (int d0 = 0; d0 < 8; ++d0) { const int cb = (d0 * 16 + hi * 8) * 2;
                  const bf16x8 b0 = *(const LAS bf16x8*)(Ks + KSWZ(r32, cb)); const bf16x8 b1 = *(const LAS bf16x8*)(Ks + 8192 + KSWZ(r32, cb));
                  p0 = __builtin_amdgcn_mfma_f32_32x32x16_bf16(b0, qr[d0], p0, 0, 0, 0);
                  p1 = __builtin_amdgcn_mfma_f32_32x32x16_bf16(b1, qr[d0], p1, 0, 0, 0);
                  if (more) AT_PIECE(d0, sn_, kon_, von_);
                  SBAR(); } }
            float al; smA(p0, p1, m_reg, al);
            if (__any(al < 1.f)) { if (hi == 0) al_l[r32] = al; asm volatile("s_waitcnt lgkmcnt(0)" ::: "memory");
#pragma unroll
                for (int r = 0; r < 16; ++r) { const float a = al_l[crow(r, hi)];
#pragma unroll
                    for (int d = 0; d < 8; ++d) o[d][r] *= a; } }
            bf16x8 pa0, pa1, pa2, pa3; float ps = 0.f;
#pragma unroll
            for (int r = 0; r < 16; ++r) ps += p0[r];
            PK4(p0, 0, pa0); PK4(p0, 8, pa1);
            const unsigned vb0 = lds0 + st + 32768u + (unsigned)v_rd_base(lane);
#define PVR(G, D0, KS0) const s16x4 G##l0 = tr_read<(D0) * 512 + (KS0) * 8192>(vb0), G##h0 = tr_read<(D0) * 512 + (KS0) * 8192 + 4096>(vb0), G##l1 = tr_read<(D0) * 512 + ((KS0) + 1) * 8192>(vb0), G##h1 = tr_read<(D0) * 512 + ((KS0) + 1) * 8192 + 4096>(vb0), \
                G##m0 = tr_read<((D0) + 1) * 512 + (KS0) * 8192>(vb0), G##n0 = tr_read<((D0) + 1) * 512 + (KS0) * 8192 + 4096>(vb0), G##m1 = tr_read<((D0) + 1) * 512 + ((KS0) + 1) * 8192>(vb0), G##n1 = tr_read<((D0) + 1) * 512 + ((KS0) + 1) * 8192 + 4096>(vb0)
#define PVM(G, OA, OB, PX, PY) do { asm volatile("s_waitcnt lgkmcnt(0)" ::: "memory"); SBAR(); \
                OA = __builtin_amdgcn_mfma_f32_32x32x16_bf16(PX, PKLH(G##l0, G##h0), OA, 0, 0, 0); OA = __builtin_amdgcn_mfma_f32_32x32x16_bf16(PY, PKLH(G##l1, G##h1), OA, 0, 0, 0); \
                OB = __builtin_amdgcn_mfma_f32_32x32x16_bf16(PX, PKLH(G##m0, G##n0), OB, 0, 0, 0); OB = __builtin_amdgcn_mfma_f32_32x32x16_bf16(PY, PKLH(G##m1, G##n1), OB, 0, 0, 0); } while (0)
            PVR(ga, 0, 0);
            PVM(ga, o[0], o[1], pa0, pa1); PVR(gb, 2, 0);
#pragma unroll
            for (int r = 0; r < 4; ++r) { p1[r] = __builtin_amdgcn_exp2f(p1[r]); ps += p1[r]; }
            PVM(gb, o[2], o[3], pa0, pa1); PVR(gc, 4, 0);
#pragma unroll
            for (int r = 4; r < 8; ++r) { p1[r] = __builtin_amdgcn_exp2f(p1[r]); ps += p1[r]; }
            PK4(p1, 0, pa2);
            PVM(gc, o[4], o[5], pa0, pa1); PVR(gd, 6, 0);
#pragma unroll
            for (int r = 8; r < 12; ++r) { p1[r] = __builtin_amdgcn_exp2f(p1[r]); ps += p1[r]; }
            PVM(gd, o[6], o[7], pa0, pa1); PVR(ge, 0, 2);
#pragma unroll
            for (int r = 12; r < 16; ++r) { p1[r] = __builtin_amdgcn_exp2f(p1[r]); ps += p1[r]; }
            PK4(p1, 8, pa3);
            { auto rr = __builtin_amdgcn_permlane32_swap(__float_as_uint(ps), __float_as_uint(ps), false, false); ps = __uint_as_float(rr[0]) + __uint_as_float(rr[1]); }
            l_reg = l_reg * al + ps;
            PVM(ge, o[0], o[1], pa2, pa3); PVR(gf, 2, 2);
            PVM(gf, o[2], o[3], pa2, pa3); PVR(gg, 4, 2);
            PVM(gg, o[4], o[5], pa2, pa3); PVR(gh, 6, 2);
            PVM(gh, o[6], o[7], pa2, pa3);
#undef PVR
#undef PVM
            asm volatile("s_waitcnt vmcnt(0)" ::: "memory"); MK_BAR();
        }
#undef AT_ISSUE
#undef AT_PIECE
        float lam;
        { float a = P.lq1[lane] * P.lk1[lane] + P.lq1[lane + 64] * P.lk1[lane + 64], b = P.lq2[lane] * P.lk2[lane] + P.lq2[lane + 64] * P.lk2[lane + 64];
    #pragma unroll
          for (int o = 32; o >= 1; o >>= 1) { a += __shfl_xor(a, o); b += __shfl_xor(b, o); }
          lam = __expf(a) - __expf(b) + 0.2f; }
        if (hi == 0) li_l[r32] = l_reg; asm volatile("s_waitcnt lgkmcnt(0)" ::: "memory");
        LAS unsigned char* reg = lds + wq * 32768;
        if (map == 1) {
#pragma unroll
            for (int r = 0; r < 16; ++r) { const float s = lam * __builtin_amdgcn_rcpf(li_l[crow(r, hi)]);
#pragma unroll
                for (int d = 0; d < 8; ++d) *(LAS float*)(reg + ((d * 16 + r) * 64 + lane) * 4) = o[d][r] * s; }
        }
        MK_BAR();
        if (map == 0) {
#pragma unroll
            for (int r = 0; r < 16; ++r) { const float s = __builtin_amdgcn_rcpf(li_l[crow(r, hi)]);
#pragma unroll
                for (int d = 0; d < 8; ++d) o[d][r] = o[d][r] * s - *(const LAS float*)(reg + ((d * 16 + r) * 64 + lane) * 4); }
            asm volatile("s_waitcnt lgkmcnt(0)" ::: "memory");
#pragma unroll
            for (int r = 0; r < 16; ++r)
#pragma unroll
                for (int d = 0; d < 8; ++d) *(LAS float*)(reg + (crow(r, hi) * 256 + d * 32 + r32) * 4) = o[d][r];
        }
        MK_BAR();
        subln_gate_store(lds, P.da_subln_g, 0.8f, gbuf + qrow0 * 2048 + head * 256, qbuf + qrow0 * 2048 + head * 256, 2048);
        MK_BAR();
    }
}

__device__ __forceinline__ void ret_chain_phase(const Params& P, LAS unsigned char* lds) {
    const int tid = mk_opaque_tid(), wid = __builtin_amdgcn_readfirstlane(tid >> 6), lane = tid & 63, r32 = lane & 31, hi = lane >> 5;
    const int sr = tid >> 4, sc = (tid & 15) * 8, m0 = wid & 3, nb0 = 2 * (wid >> 2);
    const bf16_t* rk = (const bf16_t*)(P.ws + OFF_RK); const bf16_t* rv = (const bf16_t*)(P.ws + OFF_RV);
    const unsigned lds0 = (unsigned)(size_t)lds;
    const unsigned abase = lds0 + (unsigned)v_rd_base(lane) + (unsigned)m0 * 512u, bbase = lds0 + 32768u + (unsigned)v_rd_base(lane) + (unsigned)nb0 * 512u;
    for (int cid = blockIdx.x; cid < GSEQ * 8 * 4; cid += gridDim.x) {
        const int dvh = cid & 1, dir = (cid >> 1) & 1, head = (cid >> 2) & 7, seq = cid >> 5;
        const float lg = -__expf((dir ? P.ret_decay_bwd : P.ret_decay_fwd)[head]) * LOG2E;
        const float cdec = __builtin_amdgcn_exp2f(128.f * lg);
        const bf16_t* kb = rk + (size_t)seq * SEQ * 1024 + head * 128 + sc;
        const bf16_t* vb = rv + (size_t)seq * SEQ * 2048 + head * 256 + dvh * 128 + sc;
        bf16_t* Sbase = (bf16_t*)(P.ws + (dir ? OFF_SB : OFF_SF)) + (size_t)((seq * 8 + head) * 32) * 32768;
        f32x16 acc[2]; acc[0] = f32x16{}; acc[1] = f32x16{};
        bf16x8 kreg[4], vreg[4];
        int c = dir ? 31 : 0;
#pragma unroll
        for (int i = 0; i < 4; ++i) { kreg[i] = *(const bf16x8*)(kb + (size_t)(c * 128 + sr + 32 * i) * 1024); vreg[i] = *(const bf16x8*)(vb + (size_t)(c * 128 + sr + 32 * i) * 2048); }
#define CH_STORE(cc_) do { bf16_t* Sc = Sbase + (size_t)(cc_) * 32768; \
            _Pragma("unroll") for (int nb = 0; nb < 2; ++nb) _Pragma("unroll") for (int q4 = 0; q4 < 4; ++q4) { const int dv = dvh * 128 + 32 * (nb0 + nb) + r32, dk = 32 * m0 + 8 * q4 + 4 * hi; \
                uint2 w; w.x = cvt_pk_bf16(acc[nb][4 * q4 + 0], acc[nb][4 * q4 + 1]); w.y = cvt_pk_bf16(acc[nb][4 * q4 + 2], acc[nb][4 * q4 + 3]); *(uint2*)(Sc + dv * 128 + dk) = w; } } while (0)
        CH_STORE(c);
        for (int s = 0; s < 31; ++s) {
#pragma unroll
            for (int i = 0; i < 4; ++i) { const int j = sr + 32 * i; const float f = __builtin_amdgcn_exp2f(lg * (float)(dir ? j : 127 - j));
                *(LAS bf16x8*)(lds + v_st<4>(j, sc)) = scale8(kreg[i], f); *(LAS bf16x8*)(lds + 32768 + v_st<4>(j, sc)) = vreg[i]; }
            const int cn = dir ? c - 1 : c + 1;
            if (s + 1 < 31) {
#pragma unroll
                for (int i = 0; i < 4; ++i) { kreg[i] = *(const bf16x8*)(kb + (size_t)(cn * 128 + sr + 32 * i) * 1024); vreg[i] = *(const bf16x8*)(vb + (size_t)(cn * 128 + sr + 32 * i) * 2048); } }
            __syncthreads();
#pragma unroll
            for (int r = 0; r < 16; ++r) { acc[0][r] *= cdec; acc[1][r] *= cdec; }
#define CH_STEP(KS) do { const s16x4 al_ = tr_read<(KS) * 4096>(abase), ah_ = tr_read<(KS) * 4096 + 2048>(abase); \
                const s16x4 b0l_ = tr_read<(KS) * 4096>(bbase), b0h_ = tr_read<(KS) * 4096 + 2048>(bbase), b1l_ = tr_read<512 + (KS) * 4096>(bbase), b1h_ = tr_read<512 + (KS) * 4096 + 2048>(bbase); \
                asm volatile("s_waitcnt lgkmcnt(0)" ::: "memory"); SBAR(); \
                acc[0] = __builtin_amdgcn_mfma_f32_32x32x16_bf16(PKLH(al_, ah_), PKLH(b0l_, b0h_), acc[0], 0, 0, 0); \
                acc[1] = __builtin_amdgcn_mfma_f32_32x32x16_bf16(PKLH(al_, ah_), PKLH(b1l_, b1h_), acc[1], 0, 0, 0); } while (0)
            CH_STEP(0); CH_STEP(1); CH_STEP(2); CH_STEP(3); CH_STEP(4); CH_STEP(5); CH_STEP(6); CH_STEP(7);
#undef CH_STEP
            __syncthreads();
            c = cn;
            CH_STORE(c);
        }
#undef CH_STORE
    }
}

template <int D0> __device__ __forceinline__ void ro_pv(f32x16& od, unsigned vb, const bf16x8 (&pa)[8]) {
    const s16x4 l0 = tr_read<D0 * 512 + 0 * 8192>(vb), h0 = tr_read<D0 * 512 + 0 * 8192 + 4096>(vb), l1 = tr_read<D0 * 512 + 1 * 8192>(vb), h1 = tr_read<D0 * 512 + 1 * 8192 + 4096>(vb);
    const s16x4 l2 = tr_read<D0 * 512 + 2 * 8192>(vb), h2 = tr_read<D0 * 512 + 2 * 8192 + 4096>(vb), l3 = tr_read<D0 * 512 + 3 * 8192>(vb), h3 = tr_read<D0 * 512 + 3 * 8192 + 4096>(vb);
    const s16x4 l4 = tr_read<D0 * 512 + 4 * 8192>(vb), h4 = tr_read<D0 * 512 + 4 * 8192 + 4096>(vb), l5 = tr_read<D0 * 512 + 5 * 8192>(vb), h5 = tr_read<D0 * 512 + 5 * 8192 + 4096>(vb);
    const s16x4 l6 = tr_read<D0 * 512 + 6 * 8192>(vb), h6 = tr_read<D0 * 512 + 6 * 8192 + 4096>(vb), l7 = tr_read<D0 * 512 + 7 * 8192>(vb), h7 = tr_read<D0 * 512 + 7 * 8192 + 4096>(vb);
    asm volatile("s_waitcnt lgkmcnt(0)" ::: "memory"); SBAR();
    od = __builtin_amdgcn_mfma_f32_32x32x16_bf16(pa[0], PKLH(l0, h0), od, 0, 0, 0); od = __builtin_amdgcn_mfma_f32_32x32x16_bf16(pa[1], PKLH(l1, h1), od, 0, 0, 0);
    od = __builtin_amdgcn_mfma_f32_32x32x16_bf16(pa[2], PKLH(l2, h2), od, 0, 0, 0); od = __builtin_amdgcn_mfma_f32_32x32x16_bf16(pa[3], PKLH(l3, h3), od, 0, 0, 0);
    od = __builtin_amdgcn_mfma_f32_32x32x16_bf16(pa[4], PKLH(l4, h4), od, 0, 0, 0); od = __builtin_amdgcn_mfma_f32_32x32x16_bf16(pa[5], PKLH(l5, h5), od, 0, 0, 0);
    od = __builtin_amdgcn_mfma_f32_32x32x16_bf16(pa[6], PKLH(l6, h6), od, 0, 0, 0); od = __builtin_amdgcn_mfma_f32_32x32x16_bf16(pa[7], PKLH(l7, h7), od, 0, 0, 0);
}
__device__ __forceinline__ void ret_out_phase(const Params& P, LAS unsigned char* lds) {
    for (int it = blockIdx.x; it < GSEQ * 8 * 32; it += gridDim.x) {
        const int tid = mk_opaque_tid(), wid = __builtin_amdgcn_readfirstlane(tid >> 6), lane = tid & 63, r32 = lane & 31, hi = lane >> 5;
        const int wq = wid & 3, wh = wid >> 2;
        const bf16_t* rq = (const bf16_t*)(P.ws + OFF_RQ); const bf16_t* rk = (const bf16_t*)(P.ws + OFF_RK); bf16_t* rv = (bf16_t*)(P.ws + OFF_RV); const bf16_t* rg = (const bf16_t*)(P.ws + OFF_RG);
        const bf16_t* SF = (const bf16_t*)(P.ws + OFF_SF); const bf16_t* SB = (const bf16_t*)(P.ws + OFF_SB);
        const unsigned lds0 = (unsigned)(size_t)lds;
        LAS unsigned char* bufA = lds; LAS unsigned char* bufB = lds + 65536;
        const int rowL = 4 * wid + (lane >> 4), chL = ((lane & 15) ^ (4 * (wid & 1) + (lane >> 4))) * 8;
        const unsigned kL = (unsigned)(rowL * 1024 + chL) * 2u, sL = (unsigned)(rowL * 128 + chL) * 2u;
        const unsigned vL = (unsigned)((8 * ((lane >> 4) & 1) + 4 * (wid >> 2) + ((lane >> 2) & 3)) * 2048 + (2 * (wid & 3) + (lane >> 5)) * 32 + (lane & 3) * 8) * 2u;
        const int chunk = it & 31, head = (it >> 5) & 7, seq = it >> 8;
        const size_t tokc = (size_t)seq * SEQ + chunk * 128;
        const float lgf = -__expf(P.ret_decay_fwd[head]) * LOG2E, lgb = -__expf(P.ret_decay_bwd[head]) * LOG2E;
        const char* SfT = (const char*)(SF + (size_t)((seq * 8 + head) * 32 + chunk) * 32768); const char* SbT = (const char*)(SB + (size_t)((seq * 8 + head) * 32 + chunk) * 32768);
        const char* kbp = (const char*)(rk + tokc * 1024 + head * 128); const char* vbp = (const char*)(rv + tokc * 2048 + head * 256);
#pragma unroll
        for (int i = 0; i < 4; ++i) __builtin_amdgcn_global_load_lds((const unsigned*)(kbp + (kL + (unsigned)i * (32u * 2048u))), (LAS unsigned*)(bufB + i * 8192 + wid * 1024), 16, 0, 2);
#pragma unroll
        for (int i = 0; i < 8; ++i) __builtin_amdgcn_global_load_lds((const unsigned*)(vbp + (vL + (unsigned)i * (16u * 4096u))), (LAS unsigned*)(bufA + i * 8192 + wid * 1024), 16, 0, 2);
        bf16x8 qr[8];
        { const bf16_t* qp = rq + (tokc + wq * 32 + r32) * 1024 + head * 128 + hi * 8;
#pragma unroll
          for (int d0 = 0; d0 < 8; ++d0) qr[d0] = *(const bf16x8*)(qp + d0 * 16); }
        asm volatile("s_waitcnt vmcnt(0)" ::: "memory"); MK_BAR();
        const int n = 32 * wq + r32;
        bf16x8 pa[8];
#pragma unroll
        for (int kb = 0; kb < 4; ++kb) { f32x16 p = f32x16{};
#pragma unroll
            for (int d0 = 0; d0 < 8; ++d0) { const bf16x8 a = *(const LAS bf16x8*)(bufB + kb * 8192 + KSWZ(r32, (d0 * 16 + hi * 8) * 2)); p = __builtin_amdgcn_mfma_f32_32x32x16_bf16(a, qr[d0], p, 0, 0, 0); }
#pragma unroll
            for (int r = 0; r < 16; ++r) { const int d = n - (32 * kb + crow(r, hi)); const float e = d >= 0 ? (float)d * lgf : (float)(-d) * lgb; p[r] *= __builtin_amdgcn_exp2f(e); }
            PK4(p, 0, pa[2 * kb]); PK4(p, 8, pa[2 * kb + 1]); SBAR(); }
        MK_BAR();
#pragma unroll
        for (int i = 0; i < 8; ++i) __builtin_amdgcn_global_load_lds((const unsigned*)(SfT + (sL + (unsigned)i * 8192u)), (LAS unsigned*)(bufB + i * 8192 + wid * 1024), 16, 0, 2);
        f32x16 o[4];
#pragma unroll
        for (int d = 0; d < 4; ++d) o[d] = f32x16{};
        { const unsigned vb0 = lds0 + (unsigned)v_rd_base(lane) + (unsigned)(4 * wh) * 512u;
          ro_pv<0>(o[0], vb0, pa); ro_pv<1>(o[1], vb0, pa); ro_pv<2>(o[2], vb0, pa); ro_pv<3>(o[3], vb0, pa); }
        MK_BAR();
#pragma unroll
        for (int i = 0; i < 8; ++i) __builtin_amdgcn_global_load_lds((const unsigned*)(SbT + (sL + (unsigned)i * 8192u)), (LAS unsigned*)(bufA + i * 8192 + wid * 1024), 16, 0, 2);
        asm volatile("s_waitcnt vmcnt(8)" ::: "memory"); MK_BAR();
        { const float qs = __builtin_amdgcn_exp2f(lgf * (float)(n + 1));
#pragma unroll
          for (int ks = 0; ks < 8; ++ks) { const bf16x8 qf = scale8(qr[ks], qs);
#pragma unroll
              for (int d0 = 0; d0 < 4; ++d0) { const bf16x8 b = *(const LAS bf16x8*)(bufB + (128 * wh + 32 * d0) * 256 + KSWZ(r32, (16 * ks + 8 * hi) * 2)); o[d0] = __builtin_amdgcn_mfma_f32_32x32x16_bf16(qf, b, o[d0], 0, 0, 0); } } }
        asm volatile("s_waitcnt vmcnt(0)" ::: "memory"); MK_BAR();
        { const float qs = __builtin_amdgcn_exp2f(lgb * (float)(128 - n));
#pragma unroll
          for (int ks = 0; ks < 8; ++ks) { const bf16x8 qf = scale8(qr[ks], qs);
#pragma unroll
              for (int d0 = 0; d0 < 4; ++d0) { const bf16x8 b = *(const LAS bf16x8*)(bufA + (128 * wh + 32 * d0) * 256 + KSWZ(r32, (16 * ks + 8 * hi) * 2)); o[d0] = __builtin_amdgcn_mfma_f32_32x32x16_bf16(qf, b, o[d0], 0, 0, 0); } } }
        MK_BAR();
#pragma unroll
        for (int r = 0; r < 16; ++r)
#pragma unroll
            for (int d = 0; d < 4; ++d) *(LAS float*)(lds + ((32 * wq + crow(r, hi)) * 256 + 128 * wh + 32 * d + r32) * 4) = o[d][r];
        MK_BAR();
        subln_gate_store(lds, P.ret_subln_g, 1.0f, rg + tokc * 2048 + head * 256, rv + tokc * 2048 + head * 256, 2048);
        MK_BAR();
    }
}

__global__ void __launch_bounds__(512) mega(Params P) {
    extern __shared__ __attribute__((aligned(16))) unsigned char shm[];
    LAS unsigned char* lds = (LAS unsigned char*)shm;
    cg::grid_group grid = cg::this_grid();
    volatile LAS unsigned* xst = (volatile LAS unsigned*)(lds + LDS_BYTES - 16);
    if (threadIdx.x == 0) { xst[0] = 0u; xst[1] = 0u; }
    __syncthreads();
    const XcdBarrier xb = xcd_barrier_post((unsigned*)(P.ws + OFF_BAR), xst);
    bf16_t* H = (bf16_t*)(P.ws + OFF_H); bf16_t* big = (bf16_t*)(P.ws + OFF_BIG);
    const bf16_t* WinDA = (const bf16_t*)(P.ws + OFF_WIN_DA); const bf16_t* WoutDA = (const bf16_t*)(P.ws + OFF_WOUT_DA);
    const bf16_t* WinRET = (const bf16_t*)(P.ws + OFF_WIN_RET); const bf16_t* WoutRET = (const bf16_t*)(P.ws + OFF_WOUT_RET);
    const float* tab = (const float*)(P.ws + OFF_TAB);
    prep_phase(P, lds);
    norm_to_bf16(P.x_prompt, P.norm_g, H, MR);
    grid.sync();
    bf16_t* D0 = (bf16_t*)(P.ws + OFF_D0); bf16_t* D1 = (bf16_t*)(P.ws + OFF_D1);
    for (int r = 0; r < NROUND; ++r) {
        const float* xin = r < 2 ? P.x_prompt + (size_t)r * MR * DM : P.x_sample;
        float* xio = P.out + (size_t)r * MR * DM;
        { EpiDA E; E.big = big; E.tcos = tab; E.tsin = tab + 262144; run_gemm(lds, H, WinDA, MR, 8192, 1024, E); }
        if (r > 0) { const float* xp = (r - 1) < 2 ? P.x_prompt + (size_t)(r - 1) * MR * DM : P.x_sample; comb2_norm_out(xp, D0, D1, P.final_norm_g, P.out + (size_t)(r - 1) * MR * DM, MR); }
        xcd_barrier(xb);
        attn_phase(P, lds);
        xcd_barrier(xb);
        { EpiDelta E; E.D = D0; run_gemm(lds, big, WoutDA, MR, 1024, 2048, E); }
        xcd_barrier(xb);
        comb_norm_to_bf16(xin, D0, nullptr, P.norm_g + DM, H, MR);
        xcd_barrier(xb);
        { EpiRET E; E.rq = (bf16_t*)(P.ws + OFF_RQ); E.rk = (bf16_t*)(P.ws + OFF_RK); E.rv = (bf16_t*)(P.ws + OFF_RV); E.rg = (bf16_t*)(P.ws + OFF_RG); E.tcos = tab + 2 * 262144; E.tsin = tab + 3 * 262144;
          run_gemm(lds, H, WinRET, MR, 6144, 1024, E); }
        xcd_barrier(xb);
        ret_chain_phase(P, lds);
        xcd_barrier(xb);
        ret_out_phase(P, lds);
        xcd_barrier(xb);
        { EpiDelta E; E.D = D1; run_gemm(lds, (const bf16_t*)(P.ws + OFF_RV), WoutRET, MR, 1024, 2048, E); }
        if (r + 1 < NROUND) { const float* xn = (r + 1) < 2 ? P.x_prompt + (size_t)(r + 1) * MR * DM : P.x_sample; norm_to_bf16(xn, P.norm_g, H, MR); }
        xcd_barrier(xb);
    }
    comb2_norm_out(P.x_sample, D0, D1, P.final_norm_g, P.out + (size_t)(NROUND - 1) * MR * DM, MR);
}
}

extern "C" void kernel_launch(void* const* d_in, const int* in_sizes, int n_in, void* d_out, int out_size, void* d_ws, size_t ws_size, hipStream_t stream) {
    static int grid_blocks = 0;
    if (!grid_blocks) {
        if (hipFuncSetAttribute((const void*)mk::mega, hipFuncAttributeMaxDynamicSharedMemorySize, (int)mk::LDS_BYTES) != hipSuccess) fprintf(stderr, "kernel_launch: LDS attribute failed\n");
        int dev = 0, cus = 0, per = 0; hipGetDevice(&dev); hipDeviceGetAttribute(&cus, hipDeviceAttributeMultiprocessorCount, dev);
        hipOccupancyMaxActiveBlocksPerMultiprocessor(&per, mk::mega, 512, mk::LDS_BYTES);
        if (per < 1) fprintf(stderr, "kernel_launch: occupancy query says %d blocks/CU\n", per);
        grid_blocks = cus > 0 ? cus : 256;
    }
    mk::Params p{};
    p.x_prompt = (const float*)d_in[0]; p.x_sample = (const float*)d_in[1]; p.norm_g = (const float*)d_in[2]; p.da_w_in = (const float*)d_in[3];
    p.lq1 = (const float*)d_in[4]; p.lk1 = (const float*)d_in[5]; p.lq2 = (const float*)d_in[6]; p.lk2 = (const float*)d_in[7];
    p.da_subln_g = (const float*)d_in[8]; p.da_w_out = (const float*)d_in[9]; p.ret_w_in = (const float*)d_in[10]; p.ret_decay_fwd = (const float*)d_in[11];
    p.ret_decay_bwd = (const float*)d_in[12]; p.ret_subln_g = (const float*)d_in[13]; p.ret_w_out = (const float*)d_in[14]; p.final_norm_g = (const float*)d_in[15];
    p.out = (float*)d_out; p.ws = (unsigned char*)d_ws;
    if (hipMemsetAsync((unsigned char*)d_ws + mk::OFF_BAR, 0, (size_t)XCD_BAR_WORDS * 4, stream) != hipSuccess) fprintf(stderr, "kernel_launch: barrier memset failed\n");
    void* args[] = {&p};
    hipError_t e = hipLaunchCooperativeKernel((void*)mk::mega, dim3(grid_blocks), dim3(512), args, (unsigned)mk::LDS_BYTES, stream);
    if (e != hipSuccess) fprintf(stderr, "kernel_launch: cooperative launch failed: %s (grid %d)\n", hipGetErrorString(e), grid_blocks);
}
```

```cpp
#include <hip/hip_runtime.h>
#include <hip/hip_cooperative_groups.h>
#include <cstdio>
namespace cg = cooperative_groups;
__device__ __forceinline__ int mk_opaque_tid() { int t = threadIdx.x; asm volatile("" : "+v"(t)); return t; }
namespace pg8 {
#define PG8_LAS __attribute__((address_space(3)))
typedef unsigned short bf16_t;
typedef short bf16x8 __attribute__((ext_vector_type(8)));
typedef float f32x4 __attribute__((ext_vector_type(4)));
typedef unsigned u32x4 __attribute__((ext_vector_type(4)));
constexpr int BM = 256, BK = 64, HALF = 128, HTB = HALF * BK * 2  , STAGE_BYTES = 8 * HTB, NXCD = 8, WGM = 8;

__host__ __device__ __forceinline__ int lds_byte(int r, int c) { const int st = (r >> 4) * 2 + (c >> 5), rr = r & 15, cc = c & 31, ob = rr * 64 + cc * 2; return st * 1024 + (ob ^ (((ob >> 9) & 1) << 5)); }
__host__ __device__ __forceinline__ void stage_rc(int b, int& R, int& C) { const int st = b / 1024, sb = b % 1024, swz = sb ^ (((sb >> 9) & 1) << 5); R = (st >> 1) * 16 + swz / 64; C = (st & 1) * 32 + (swz % 64) / 2; }
__host__ __device__ __forceinline__ int perm32(int rho) { const int n = rho >> 4, i = rho & 15; return 8 * (i >> 2) + 4 * n + (i & 3); }

struct Unit { int pm, pn; };
struct Gemm { const bf16_t* A; const bf16_t* Bt; int M, N, K; };

struct StaticOrder {
    int nM, nN, nwg, G, c;
    __host__ __device__ void init(int M, int N, int G_, int c_) { nM = M / BM; nN = N / BM; nwg = nM * nN; G = G_; c = c_; }
    __host__ __device__ bool next(int i, Unit& u) const {
        const long L = (long)i * G + c; if (L >= nwg) return false;
        int wgid = (int)L; { const int q = nwg / NXCD, r = nwg % NXCD, xcd = wgid % NXCD, off = wgid / NXCD; wgid = (xcd < r ? xcd * (q + 1) : r * (q + 1) + (xcd - r) * q) + off; }
        const int nig = WGM * nN, gid = wgid / nig, fm = gid * WGM, gsz = (nM - fm) < WGM ? (nM - fm) : WGM;
        u.pm = fm + ((wgid % nig) % gsz); u.pn = (wgid % nig) / gsz; return true;
    }
    __device__ __forceinline__ void a_ready(const Unit&) const {}
    __device__ __forceinline__ void done(const Unit&) const {}
};
__device__ __forceinline__ unsigned cvt_pk_bf16(float lo, float hi) { unsigned r; asm volatile("v_cvt_pk_bf16_f32 %0, %1, %2" : "=v"(r) : "v"(lo), "v"(hi)); return r; }
template <class Epi, class Sched, bool STAMP = false>
__device__ __forceinline__ void gemm_phase(PG8_LAS unsigned char* lds, const Gemm g, const Sched& S, const Epi& E, unsigned long long* stamps) {
    const int tid = mk_opaque_tid(), wid = __builtin_amdgcn_readfirstlane(tid >> 6), lane = tid & 63, wr = wid >> 2, wc = wid & 3, fr = lane & 15, fq = lane >> 4;
    const int K = g.K, nt = K / BK;
    int ts_lo = 0, ts_hi = 0, nts = 0; const unsigned long long rt_entry = STAMP ? (unsigned long long)wall_clock64() : 0ull;
#define PG8_STAMP() do { if (STAMP && wid == 0 && nts < 64) { const unsigned long long _c = (unsigned long long)clock64(); \
        ts_lo = (lane == nts) ? (int)(unsigned)_c : ts_lo; ts_hi = (lane == nts) ? (int)(unsigned)(_c >> 32) : ts_hi; ++nts; } } while (0)
    PG8_STAMP();
    unsigned voffA[2], voffB[2];
#pragma unroll
    for (int i = 0; i < 2; ++i) { int R, C; stage_rc(tid * 16 + i * 8192, R, C); const int Rb = Epi::PERM ? ((R & ~31) + perm32(R & 31)) : R;
        voffA[i] = (unsigned)(R * K + C) * 2u; voffB[i] = (unsigned)(Rb * K + C) * 2u; }
    const size_t kstep = (size_t)(BK * 2);
    const size_t hstep = (size_t)HALF * K * 2;
    const size_t tstep = 2 * hstep;
    const unsigned ldsw = (unsigned)wid * 1024u;
    const int aoff = lds_byte(wr * 64 + fr, fq * 8), boff = lds_byte(wc * 32 + fr, fq * 8);
#define PG8_SA(b, h) (((b) * 2 + (h)) * HTB)
#define PG8_SB(b, h) ((4 + (b) * 2 + (h)) * HTB)
#define PG8_STAGE(bufoff, gbase, voff) do { _Pragma("unroll") for (int _i = 0; _i < 2; ++_i) \
        __builtin_amdgcn_global_load_lds((const unsigned*)((const char*)(gbase) + (voff)[_i]), (PG8_LAS unsigned*)(lds + (bufoff) + ldsw + _i * 8192), 16, 0, 0); } while (0)
#define PG8_LDA(dst, b, h) do { _Pragma("unroll") for (int m = 0; m < 4; ++m) _Pragma("unroll") for (int k = 0; k < 2; ++k) dst[m][k] = *(const PG8_LAS bf16x8*)(lds + PG8_SA(b, h) + aoff + m * 2048 + k * 1024); } while (0)
#define PG8_LDB(dst, b, h) do { _Pragma("unroll") for (int n = 0; n < 2; ++n) _Pragma("unroll") for (int k = 0; k < 2; ++k) dst[n][k] = *(const PG8_LAS bf16x8*)(lds + PG8_SB(b, h) + boff + n * 2048 + k * 1024); } while (0)
#define PG8_MMA(ai, bj, At, Bt) do { __builtin_amdgcn_s_setprio(1); _Pragma("unroll") for (int m = 0; m < 4; ++m) _Pragma("unroll") for (int n = 0; n < 2; ++n) _Pragma("unroll") for (int k = 0; k < 2; ++k) \
        acc[ai][bj][m][n] = __builtin_amdgcn_mfma_f32_16x16x32_bf16(Bt[n][k], At[m][k], acc[ai][bj][m][n], 0, 0, 0); __builtin_amdgcn_s_setprio(0); } while (0)
#define PG8_WAIT_V(n) asm volatile("s_waitcnt vmcnt(" #n ")" ::: "memory")
#define PG8_WAIT_L(n) asm volatile("s_waitcnt lgkmcnt(" #n ")" ::: "memory")
#define PG8_BAR __builtin_amdgcn_s_barrier()
#define PG8_SCHED __builtin_amdgcn_sched_barrier(0)
    Unit cur, nxt; int ui = 0;
    if (!S.next(0, cur)) return;
    f32x4 acc[2][2][4][2];
#pragma unroll
    for (int a = 0; a < 2; ++a)
#pragma unroll
        for (int b = 0; b < 2; ++b)
#pragma unroll
            for (int m = 0; m < 4; ++m)
#pragma unroll
                for (int n = 0; n < 2; ++n) acc[a][b][m][n] = (f32x4){0.f, 0.f, 0.f, 0.f};
    bf16x8 At[4][2], B0[2][2], B1[2][2];
    const char* cA = (const char*)g.A + (size_t)cur.pm * tstep; const char* cB = (const char*)g.Bt + (size_t)cur.pn * tstep;
    S.a_ready(cur);
    PG8_STAGE(PG8_SB(0, 0), cB, voffB); PG8_STAGE(PG8_SA(0, 0), cA, voffA); PG8_STAGE(PG8_SB(0, 1), cB + hstep, voffB); PG8_STAGE(PG8_SA(0, 1), cA + hstep, voffA);
    if (wr == 1) PG8_BAR;
    PG8_WAIT_V(4); PG8_BAR;
    PG8_STAGE(PG8_SB(1, 0), cB + kstep, voffB); PG8_STAGE(PG8_SA(1, 0), cA + kstep, voffA); PG8_STAGE(PG8_SB(1, 1), cB + hstep + kstep, voffB);
    PG8_WAIT_V(6); PG8_BAR;
    PG8_STAMP();
    for (;;) {
        const bool has_next = S.next(ui + 1, nxt);
        const char* nA = has_next ? (const char*)g.A + (size_t)nxt.pm * tstep : cA; const char* nB = has_next ? (const char*)g.Bt + (size_t)nxt.pn * tstep : cB;
        for (int t = 0; t < nt; t += 2) {
            const bool last = (t == nt - 2);
            const char* a1 = cA + (size_t)(t + 1) * kstep;
            const char* a2 = last ? nA : cA + (size_t)(t + 2) * kstep; const char* b2 = last ? nB : cB + (size_t)(t + 2) * kstep;
            const char* a3 = a2 + kstep; const char* b3 = b2 + kstep;
            if (last && has_next) S.a_ready(nxt);
            PG8_LDB(B0, 0, 0); PG8_SCHED; PG8_LDA(At, 0, 0); PG8_STAGE(PG8_SA(1, 1), a1 + hstep, voffA);
            PG8_WAIT_L(8); PG8_BAR; PG8_WAIT_L(0); PG8_MMA(0, 0, At, B0); PG8_BAR; PG8_SCHED;
            PG8_LDB(B1, 0, 1); PG8_STAGE(PG8_SB(0, 0), b2, voffB);
            PG8_BAR; PG8_WAIT_L(0); PG8_MMA(0, 1, At, B1); PG8_BAR;
            PG8_LDA(At, 0, 1); PG8_STAGE(PG8_SA(0, 0), a2, voffA);
            PG8_BAR; PG8_WAIT_L(0); PG8_MMA(1, 0, At, B0); PG8_BAR; PG8_SCHED;
            PG8_STAGE(PG8_SB(0, 1), b2 + hstep, voffB);
            PG8_WAIT_V(6); PG8_BAR; PG8_MMA(1, 1, At, B1); PG8_BAR;
            PG8_LDB(B0, 1, 0); PG8_SCHED; PG8_LDA(At, 1, 0); PG8_STAGE(PG8_SA(0, 1), a2 + hstep, voffA);
            PG8_WAIT_L(8); PG8_BAR; PG8_WAIT_L(0); PG8_MMA(0, 0, At, B0); PG8_BAR; PG8_SCHED;
            PG8_LDB(B1, 1, 1); PG8_STAGE(PG8_SB(1, 0), b3, voffB);
            PG8_BAR; PG8_WAIT_L(0); PG8_MMA(0, 1, At, B1); PG8_BAR;
            PG8_LDA(At, 1, 1); PG8_STAGE(PG8_SA(1, 0), a3, voffA);
            PG8_BAR; PG8_WAIT_L(0); PG8_MMA(1, 0, At, B0); PG8_BAR; PG8_SCHED;
            PG8_STAGE(PG8_SB(1, 1), b3 + hstep, voffB);
            PG8_WAIT_V(6); PG8_BAR; PG8_MMA(1, 1, At, B1); PG8_BAR;
        }
        PG8_STAMP();
        if constexpr (!Epi::AFTER_DRAIN) { E(acc, cur, wr, wc, fr, fq); S.done(cur); }
        PG8_STAMP();
        if (!has_next) break;
#pragma unroll
        for (int a = 0; a < 2; ++a)
#pragma unroll
            for (int b = 0; b < 2; ++b)
#pragma unroll
                for (int m = 0; m < 4; ++m)
#pragma unroll
                    for (int n = 0; n < 2; ++n) acc[a][b][m][n] = (f32x4){0.f, 0.f, 0.f, 0.f};
        cur = nxt; cA = nA; cB = nB; ++ui;
    }
    PG8_WAIT_V(0);
    if (wr == 0) PG8_BAR;
    PG8_BAR;
    if constexpr (Epi::AFTER_DRAIN) { E.fused(acc, cur, wr, wc, fr, fq, lds, wid, lane); S.done(cur); }
    PG8_STAMP();
    if (STAMP && wid == 0) { stamps[lane] = lane < nts ? (((unsigned long long)(unsigned)ts_hi << 32) | (unsigned)ts_lo) : 0ull;
        if (lane == 62) stamps[62] = rt_entry; if (lane == 63) stamps[63] = (unsigned long long)wall_clock64(); }
#undef PG8_STAMP
#undef PG8_SA
#undef PG8_SB
#undef PG8_STAGE
#undef PG8_LDA
#undef PG8_LDB
#undef PG8_MMA
#undef PG8_WAIT_V
#undef PG8_WAIT_L
#undef PG8_BAR
#undef PG8_SCHED
}
}

namespace mk {
using pg8::bf16_t; using pg8::bf16x8; using pg8::f32x4; using pg8::u32x4; using pg8::Unit; using pg8::Gemm; using pg8::StaticOrder; using pg8::cvt_pk_bf16;
typedef short s16x4 __attribute__((ext_vector_type(4)));
typedef float f32x16 __attribute__((ext_vector_type(16)));
#define LAS __attribute__((address_space(3)))

#define XB_TMO      128
#define XB_XCNT(j)  (256  + 64 * (j))
#define XB_XSUB(j)  (1280 + 64 * (j))
#define XB_XGEN(j)  (2304 + 64 * (j))
#define XB_TOP      3328
#define XB_TOPGEN   3392
#define XCD_BAR_WORDS 3456
#define XB_SPIN_CAP (1u << 18)

__device__ __forceinline__ unsigned xb_ld(unsigned* p)              { return __hip_atomic_load(p, __ATOMIC_RELAXED, __HIP_MEMORY_SCOPE_AGENT); }
__device__ __forceinline__ unsigned xb_add(unsigned* p, unsigned v) { return __hip_atomic_fetch_add(p, v, __ATOMIC_RELAXED, __HIP_MEMORY_SCOPE_AGENT); }
__device__ __forceinline__ unsigned xb_xcc_id() { return (unsigned)__builtin_amdgcn_s_getreg((3 << 11) | 20) & 0xFu; }
#define XB_SPIN(cond, bar) do { unsigned _sp = 0; while (cond) { __builtin_amdgcn_s_sleep(1); \
    if ((++_sp & 255u) == 0u) { if (xb_ld(&(bar)[XB_TMO])) break; if (_sp > XB_SPIN_CAP) { atomicAdd(&(bar)[XB_TMO], 1u); break; } } } } while (0)

struct XcdBarrier {
    unsigned* bar; unsigned x;
    volatile LAS unsigned* st;
};

__device__ __forceinline__ XcdBarrier xcd_barrier_post(unsigned* bar, volatile LAS unsigned* st) {
    XcdBarrier b; b.bar = bar; b.x = xb_xcc_id(); b.st = st;
    if (threadIdx.x == 0) (void)xb_add(&bar[XB_XCNT(b.x)], 1u);
    return b;
}
__device__ __forceinline__ void xcd_barrier_complete(unsigned* bar, unsigned x, unsigned& nloc, unsigned& nx) {
    const unsigned G = gridDim.x * gridDim.y * gridDim.z;
    unsigned sum, cnt, mine, sp = 0u;
    for (;;) {
        sum = 0u; cnt = 0u; mine = 0u;
#pragma unroll
        for (unsigned j = 0; j < 16; ++j) { const unsigned c = xb_ld(&bar[XB_XCNT(j)]); sum += c; cnt += (c > 0u) ? 1u : 0u; mine = (j == x) ? c : mine; }
        if (sum == G) break;
        __builtin_amdgcn_s_sleep(1);
        if ((++sp & 255u) == 0u) { if (xb_ld(&bar[XB_TMO])) break; if (sp > XB_SPIN_CAP) { atomicAdd(&bar[XB_TMO], 1u); break; } }
    }
    nloc = mine > 0u ? mine : 1u; nx = cnt > 0u ? cnt : 1u;
}

__device__ __forceinline__ void xcd_barrier(const XcdBarrier& b) {
    asm volatile("s_waitcnt vmcnt(0)" ::: "memory");
    __syncthreads();
    if (threadIdx.x == 0) {
        unsigned* bar = b.bar;
        __builtin_amdgcn_s_waitcnt(0);
        unsigned nloc = b.st[0], nx = b.st[1];
        if (nloc == 0u) { xcd_barrier_complete(bar, b.x, nloc, nx); b.st[0] = nloc; b.st[1] = nx; }
        const unsigned old = xb_add(&bar[XB_XSUB(b.x)], 1u);
        const unsigned gen = old / nloc;
        if (old + 1u == (gen + 1u) * nloc) {
            __builtin_amdgcn_fence(__ATOMIC_RELEASE, "agent");
            asm volatile("s_waitcnt vmcnt(0)" ::: "memory");
            const unsigned og = xb_add(&bar[XB_TOP], 1u);
            const unsigned tg = og / nx;
            if (og + 1u == (tg + 1u) * nx) xb_add(&bar[XB_TOPGEN], 1u);
            else XB_SPIN(xb_ld(&bar[XB_TOPGEN]) == tg, bar);
            __builtin_amdgcn_fence(__ATOMIC_ACQUIRE, "agent");
            xb_add(&bar[XB_XGEN(b.x)], 1u);
            asm volatile("s_waitcnt vmcnt(0)" ::: "memory");
        } else {
            XB_SPIN(xb_ld(&bar[XB_XGEN(b.x)]) == gen, bar);
            __builtin_amdgcn_fence(__ATOMIC_ACQUIRE, "agent");
            asm volatile("s_waitcnt vmcnt(0)" ::: "memory");
        }
    }
    __syncthreads();
}


constexpr int SEQ = 4096, DM = 1024, DI = 2048, GSEQ = 8, MR = GSEQ * SEQ, NROUND = 3;
constexpr size_t LDS_BYTES = 136 * 1024;
constexpr size_t OFF_WIN_DA = 0, OFF_WOUT_DA = OFF_WIN_DA + (size_t)8192 * 1024 * 2, OFF_WIN_RET = OFF_WOUT_DA + (size_t)1024 * 2048 * 2,
                 OFF_WOUT_RET = OFF_WIN_RET + (size_t)6144 * 1024 * 2, OFF_TAB = OFF_WOUT_RET + (size_t)1024 * 2048 * 2,
                 OFF_H = OFF_TAB + (size_t)4 * 4096 * 64 * 4, OFF_BIG = OFF_H + (size_t)MR * DM * 2;
constexpr size_t SZ_2048 = (size_t)MR * 2048 * 2, SZ_1024 = (size_t)MR * 1024 * 2;
constexpr size_t OFF_D0 = OFF_BIG + (size_t)5 * ((size_t)MR * 2048 * 2) + 1048576, OFF_D1 = OFF_D0 + (size_t)3 * MR * DM * 2, OFF_BAR = OFF_D1 + (size_t)MR * DM * 2;
constexpr size_t OFF_RQ = OFF_BIG, OFF_RK = OFF_RQ + SZ_1024, OFF_RV = OFF_RK + SZ_1024, OFF_RG = OFF_RV + SZ_2048, OFF_SF = OFF_RG + SZ_2048, OFF_SB = OFF_SF + SZ_2048;

struct Params {
    const float* x_prompt; const float* x_sample; const float* norm_g; const float* da_w_in; const float* lq1; const float* lk1; const float* lq2; const float* lk2;
    const float* da_subln_g; const float* da_w_out; const float* ret_w_in; const float* ret_decay_fwd; const float* ret_decay_bwd; const float* ret_subln_g;
    const float* ret_w_out; const float* final_norm_g; float* out; unsigned char* ws;
};

__device__ __forceinline__ unsigned short f2bf(float f) { unsigned u = __float_as_uint(f); u += 0x7FFFu + ((u >> 16) & 1u); return (unsigned short)(u >> 16); }
__device__ __forceinline__ float bflo(unsigned w) { return __uint_as_float(w << 16); }
__device__ __forceinline__ float bfhi(unsigned w) { return __uint_as_float(w & 0xffff0000u); }
__device__ __forceinline__ bf16x8 scale8(bf16x8 x, float f) {
    u32x4 w = *reinterpret_cast<u32x4*>(&x); u32x4 r;
    r.x = cvt_pk_bf16(bflo(w.x) * f, bfhi(w.x) * f); r.y = cvt_pk_bf16(bflo(w.y) * f, bfhi(w.y) * f);
    r.z = cvt_pk_bf16(bflo(w.z) * f, bfhi(w.z) * f); r.w = cvt_pk_bf16(bflo(w.w) * f, bfhi(w.w) * f);
    return *reinterpret_cast<bf16x8*>(&r);
}
#define MK_BAR() do { asm volatile("" ::: "memory"); __builtin_amdgcn_s_barrier(); asm volatile("" ::: "memory"); } while (0)
#define SBAR() __builtin_amdgcn_sched_barrier(0)
#define KSWZ(row, colB) ((row) * 256 + ((colB) ^ (((row) & 7) << 4)))
__device__ __forceinline__ int crow(int r, int hi) { return (r & 3) + 8 * (r >> 2) + 4 * hi; }
template <int NCG> __device__ __forceinline__ int v_st(int k, int c) { const int kk = (k & ~0xC) | ((k & 4) << 1) | ((k & 8) >> 1); return ((kk >> 3) * NCG + (c >> 5)) * 512 + ((kk & 7) * 32 + (c & 31)) * 2; }
__device__ __forceinline__ int v_rd_base(int lane) { return ((lane & 3) << 3) | (((lane >> 2) & 3) << 6) | (((lane >> 4) & 1) << 5) | (((lane >> 5) & 1) << 8); }
template <int OFF> __device__ __forceinline__ s16x4 tr_read(unsigned vb) {
    s16x4 r; asm volatile("ds_read_b64_tr_b16 %0, %1 offset:%2" : "=&v"(r) : "v"(vb), "i"(OFF) : "memory"); return r;
}
#define PKLH(L, H) (bf16x8){L[0], L[1], L[2], L[3], H[0], H[1], H[2], H[3]}
#define PK4(P, BASE, OUT) do { unsigned a0 = cvt_pk_bf16(P[BASE + 0], P[BASE + 1]), a1 = cvt_pk_bf16(P[BASE + 2], P[BASE + 3]);   \
    unsigned b0 = cvt_pk_bf16(P[BASE + 4], P[BASE + 5]), b1 = cvt_pk_bf16(P[BASE + 6], P[BASE + 7]);                              \
    auto r0 = __builtin_amdgcn_permlane32_swap(a0, b0, false, false); auto r1 = __builtin_amdgcn_permlane32_swap(a1, b1, false, false); \
    u32x4 w_ = {r0[0], r1[0], r0[1], r1[1]}; OUT = *reinterpret_cast<bf16x8*>(&w_); } while (0)

__device__ __forceinline__ void transpose_tile(const float* __restrict__ W, bf16_t* __restrict__ Wt, int K, int N, bool permDA, int tile, LAS float* t) {
    const int ntn = N / 64, kt = tile / ntn, nt = tile % ntn, k0 = kt * 64, n0 = nt * 64, tid = mk_opaque_tid();
#pragma unroll
    for (int i = 0; i < 8; ++i) { const int k = i * 8 + (tid >> 6), n = tid & 63; t[k * 65 + n] = W[(size_t)(k0 + k) * N + n0 + n]; }
    __syncthreads();
#pragma unroll
    for (int i = 0; i < 8; ++i) { const int n = i * 8 + (tid >> 6), k = tid & 63; const int ns = n0 + n; int nd = ns;
        if (permDA && ns < 4096) { const int d = ns & 127; nd = (ns & ~127) + (d < 64 ? 2 * d : 2 * (d - 64) + 1); }
        Wt[(size_t)nd * K + k0 + k] = f2bf(t[k * 65 + n]); }
    __syncthreads();
}
__device__ __forceinline__ void prep_phase(const Params& P, LAS unsigned char* lds) {
    LAS float* t = (LAS float*)lds;
    bf16_t* w0 = (bf16_t*)(P.ws + OFF_WIN_DA); bf16_t* w1 = (bf16_t*)(P.ws + OFF_WOUT_DA); bf16_t* w2 = (bf16_t*)(P.ws + OFF_WIN_RET); bf16_t* w3 = (bf16_t*)(P.ws + OFF_WOUT_RET);
    constexpr int T0 = 16 * 128, T1 = 32 * 16, T2 = 16 * 96, T3 = 32 * 16;
    for (int i = blockIdx.x; i < T0 + T1 + T2 + T3; i += gridDim.x) {
        if (i < T0) transpose_tile(P.da_w_in, w0, 1024, 8192, true, i, t);
        else if (i < T0 + T1) transpose_tile(P.da_w_out, w1, 2048, 1024, false, i - T0, t);
        else if (i < T0 + T1 + T2) transpose_tile(P.ret_w_in, w2, 1024, 6144, false, i - T0 - T1, t);
        else transpose_tile(P.ret_w_out, w3, 2048, 1024, false, i - T0 - T1 - T2, t);
    }
    float* tab = (float*)(P.ws + OFF_TAB);
    for (int idx = blockIdx.x * 512 + threadIdx.x; idx < 2 * 4096 * 64; idx += gridDim.x * 512) {
        const int which = idx >> 18, e = idx & 262143, pos = e >> 6, i = e & 63;
        const double ex = which ? (double)i / 63.0 : (double)i / 64.0;
        const float inv = (float)exp(-ex * 9.210340371976184);
        const float ang = (float)pos * inv;
        double rev = (double)ang * 0.15915494309189535; rev -= rint(rev);
        const float rr = (float)(rev * 6.283185307179586);
        tab[(size_t)(which * 2) * 262144 + e] = __cosf(rr); tab[(size_t)(which * 2 + 1) * 262144 + e] = __sinf(rr);
    }
}

__device__ __forceinline__ void norm_to_bf16(const float* __restrict__ X, const float* __restrict__ g, bf16_t* __restrict__ H, int rows) {
    const int tid_ = mk_opaque_tid(), lane = tid_ & 63, gw = blockIdx.x * 8 + (tid_ >> 6), nw = gridDim.x * 8;
    f32x4 gv[4];
#pragma unroll
    for (int j = 0; j < 4; ++j) gv[j] = *(const f32x4*)(g + j * 256 + lane * 4);
    for (int r0 = gw; r0 < rows; r0 += 4 * nw) {
        f32x4 v[4][4];
#pragma unroll
        for (int q = 0; q < 4; ++q)
#pragma unroll
            for (int j = 0; j < 4; ++j) v[q][j] = __builtin_nontemporal_load((const f32x4*)(X + (size_t)(r0 + q * nw) * DM + j * 256 + lane * 4));
#pragma unroll
        for (int q = 0; q < 4; ++q) { float ss = 0.f;
#pragma unroll
            for (int j = 0; j < 4; ++j) ss += v[q][j][0] * v[q][j][0] + v[q][j][1] * v[q][j][1] + v[q][j][2] * v[q][j][2] + v[q][j][3] * v[q][j][3];
#pragma unroll
            for (int o = 32; o >= 1; o >>= 1) ss += __shfl_xor(ss, o);
            const float rs = rsqrtf(ss * (1.0f / DM) + 1e-6f);
#pragma unroll
            for (int j = 0; j < 4; ++j) { uint2 w; w.x = cvt_pk_bf16(v[q][j][0] * rs * gv[j][0], v[q][j][1] * rs * gv[j][1]); w.y = cvt_pk_bf16(v[q][j][2] * rs * gv[j][2], v[q][j][3] * rs * gv[j][3]);
                *(uint2*)(H + (size_t)(r0 + q * nw) * DM + j * 256 + lane * 4) = w; } }
    }
}
__device__ __forceinline__ void norm_inplace_f32(float* __restrict__ X, const float* __restrict__ g, int rows) {
    const int tid_ = mk_opaque_tid(), lane = tid_ & 63, gw = blockIdx.x * 8 + (tid_ >> 6), nw = gridDim.x * 8;
    f32x4 gv[4];
#pragma unroll
    for (int j = 0; j < 4; ++j) gv[j] = *(const f32x4*)(g + j * 256 + lane * 4);
    for (int r0 = gw; r0 < rows; r0 += 4 * nw) {
        f32x4 v[4][4];
#pragma unroll
        for (int q = 0; q < 4; ++q)
#pragma unroll
            for (int j = 0; j < 4; ++j) v[q][j] = *(const f32x4*)(X + (size_t)(r0 + q * nw) * DM + j * 256 + lane * 4);
#pragma unroll
        for (int q = 0; q < 4; ++q) { float ss = 0.f;
#pragma unroll
            for (int j = 0; j < 4; ++j) ss += v[q][j][0] * v[q][j][0] + v[q][j][1] * v[q][j][1] + v[q][j][2] * v[q][j][2] + v[q][j][3] * v[q][j][3];
#pragma unroll
            for (int o = 32; o >= 1; o >>= 1) ss += __shfl_xor(ss, o);
            const float rs = rsqrtf(ss * (1.0f / DM) + 1e-6f);
#pragma unroll
            for (int j = 0; j < 4; ++j) { f32x4 y = {v[q][j][0] * rs * gv[j][0], v[q][j][1] * rs * gv[j][1], v[q][j][2] * rs * gv[j][2], v[q][j][3] * rs * gv[j][3]}; *(f32x4*)(X + (size_t)(r0 + q * nw) * DM + j * 256 + lane * 4) = y; } }
    }
}

__device__ __forceinline__ void comb_norm_to_bf16(const float* __restrict__ Xin, const bf16_t* __restrict__ D, float* __restrict__ Xout, const float* __restrict__ g, bf16_t* __restrict__ H, int rows) {
    const int tid_ = mk_opaque_tid(), lane = tid_ & 63, gw = blockIdx.x * 8 + (tid_ >> 6), nw = gridDim.x * 8;
    f32x4 gv[4];
#pragma unroll
    for (int j = 0; j < 4; ++j) gv[j] = *(const f32x4*)(g + j * 256 + lane * 4);
    for (int r0 = gw; r0 < rows; r0 += 4 * nw) {
        f32x4 v[4][4]; uint2 d[4][4];
#pragma unroll
        for (int q = 0; q < 4; ++q)
#pragma unroll
            for (int j = 0; j < 4; ++j) { const size_t o = (size_t)(r0 + q * nw) * DM + j * 256 + lane * 4; v[q][j] = __builtin_nontemporal_load((const f32x4*)(Xin + o)); d[q][j] = *(const uint2*)(D + o); }
#pragma unroll
        for (int q = 0; q < 4; ++q) { float ss = 0.f;
#pragma unroll
            for (int j = 0; j < 4; ++j) { v[q][j][0] += bflo(d[q][j].x); v[q][j][1] += bfhi(d[q][j].x); v[q][j][2] += bflo(d[q][j].y); v[q][j][3] += bfhi(d[q][j].y);
                ss += v[q][j][0] * v[q][j][0] + v[q][j][1] * v[q][j][1] + v[q][j][2] * v[q][j][2] + v[q][j][3] * v[q][j][3]; }
#pragma unroll
            for (int o = 32; o >= 1; o >>= 1) ss += __shfl_xor(ss, o);
            const float rs = rsqrtf(ss * (1.0f / DM) + 1e-6f);
#pragma unroll
            for (int j = 0; j < 4; ++j) { const size_t o = (size_t)(r0 + q * nw) * DM + j * 256 + lane * 4; if (Xout) *(f32x4*)(Xout + o) = v[q][j];
                uint2 w; w.x = cvt_pk_bf16(v[q][j][0] * rs * gv[j][0], v[q][j][1] * rs * gv[j][1]); w.y = cvt_pk_bf16(v[q][j][2] * rs * gv[j][2], v[q][j][3] * rs * gv[j][3]);
                *(uint2*)(H + o) = w; } }
    }
}
__device__ __forceinline__ void comb_norm_inplace_f32(float* __restrict__ X, const bf16_t* __restrict__ D, const float* __restrict__ g, int rows) {
    const int tid_ = mk_opaque_tid(), lane = tid_ & 63, gw = blockIdx.x * 8 + (tid_ >> 6), nw = gridDim.x * 8;
    f32x4 gv[4];
#pragma unroll
    for (int j = 0; j < 4; ++j) gv[j] = *(const f32x4*)(g + j * 256 + lane * 4);
    for (int r0 = gw; r0 < rows; r0 += 4 * nw) {
        f32x4 v[4][4]; uint2 d[4][4];
#pragma unroll
        for (int q = 0; q < 4; ++q)
#pragma unroll
            for (int j = 0; j < 4; ++j) { const size_t o = (size_t)(r0 + q * nw) * DM + j * 256 + lane * 4; v[q][j] = *(const f32x4*)(X + o); d[q][j] = *(const uint2*)(D + o); }
#pragma unroll
        for (int q = 0; q < 4; ++q) { float ss = 0.f;
#pragma unroll
            for (int j = 0; j < 4; ++j) { v[q][j][0] += bflo(d[q][j].x); v[q][j][1] += bfhi(d[q][j].x); v[q][j][2] += bflo(d[q][j].y); v[q][j][3] += bfhi(d[q][j].y);
                ss += v[q][j][0] * v[q][j][0] + v[q][j][1] * v[q][j][1] + v[q][j][2] * v[q][j][2] + v[q][j][3] * v[q][j][3]; }
#pragma unroll
            for (int o = 32; o >= 1; o >>= 1) ss += __shfl_xor(ss, o);
            const float rs = rsqrtf(ss * (1.0f / DM) + 1e-6f);
#pragma unroll
            for (int j = 0; j < 4; ++j) { f32x4 y = {v[q][j][0] * rs * gv[j][0], v[q][j][1] * rs * gv[j][1], v[q][j][2] * rs * gv[j][2], v[q][j][3] * rs * gv[j][3]}; *(f32x4*)(X + (size_t)(r0 + q * nw) * DM + j * 256 + lane * 4) = y; } }
    }
}

__device__ __forceinline__ void comb2_norm_out(const float* __restrict__ Xin, const bf16_t* __restrict__ Da, const bf16_t* __restrict__ Db, const float* __restrict__ g, float* __restrict__ Out, int rows) {
    const int tid_ = mk_opaque_tid(), lane = tid_ & 63, gw = blockIdx.x * 8 + (tid_ >> 6), nw = gridDim.x * 8;
    f32x4 gv[4];
#pragma unroll
    for (int j = 0; j < 4; ++j) gv[j] = *(const f32x4*)(g + j * 256 + lane * 4);
    for (int r0 = gw; r0 < rows; r0 += 4 * nw) {
        f32x4 v[4][4]; uint2 da[4][4], db[4][4];
#pragma unroll
        for (int q = 0; q < 4; ++q)
#pragma unroll
            for (int j = 0; j < 4; ++j) { const size_t o = (size_t)(r0 + q * nw) * DM + j * 256 + lane * 4; v[q][j] = __builtin_nontemporal_load((const f32x4*)(Xin + o)); { typedef unsigned u32x2v_ __attribute__((ext_vector_type(2))); const u32x2v_ ta = __builtin_nontemporal_load((const u32x2v_*)(Da + o)), tb = __builtin_nontemporal_load((const u32x2v_*)(Db + o)); da[q][j].x = ta[0]; da[q][j].y = ta[1]; db[q][j].x = tb[0]; db[q][j].y = tb[1]; } }
#pragma unroll
        for (int q = 0; q < 4; ++q) { float ss = 0.f;
#pragma unroll
            for (int j = 0; j < 4; ++j) { v[q][j][0] += bflo(da[q][j].x) + bflo(db[q][j].x); v[q][j][1] += bfhi(da[q][j].x) + bfhi(db[q][j].x); v[q][j][2] += bflo(da[q][j].y) + bflo(db[q][j].y); v[q][j][3] += bfhi(da[q][j].y) + bfhi(db[q][j].y);
                ss += v[q][j][0] * v[q][j][0] + v[q][j][1] * v[q][j][1] + v[q][j][2] * v[q][j][2] + v[q][j][3] * v[q][j][3]; }
#pragma unroll
            for (int o = 32; o >= 1; o >>= 1) ss += __shfl_xor(ss, o);
            const float rs = rsqrtf(ss * (1.0f / DM) + 1e-6f);
#pragma unroll
            for (int j = 0; j < 4; ++j) { f32x4 y = {v[q][j][0] * rs * gv[j][0], v[q][j][1] * rs * gv[j][1], v[q][j][2] * rs * gv[j][2], v[q][j][3] * rs * gv[j][3]}; __builtin_nontemporal_store(y, (f32x4*)(Out + (size_t)(r0 + q * nw) * DM + j * 256 + lane * 4)); } }
    }
}

__device__ __forceinline__ u32x4 rot_pack(f32x4 v0, f32x4 v1, const float* tc, const float* ts, float sc) {
    const f32x4 c = *(const f32x4*)tc, s = *(const f32x4*)ts; u32x4 w;
    w.x = cvt_pk_bf16((v0[0] * c[0] - v0[1] * s[0]) * sc, (v0[1] * c[0] + v0[0] * s[0]) * sc);
    w.y = cvt_pk_bf16((v0[2] * c[1] - v0[3] * s[1]) * sc, (v0[3] * c[1] + v0[2] * s[1]) * sc);
    w.z = cvt_pk_bf16((v1[0] * c[2] - v1[1] * s[2]) * sc, (v1[1] * c[2] + v1[0] * s[2]) * sc);
    w.w = cvt_pk_bf16((v1[2] * c[3] - v1[3] * s[3]) * sc, (v1[3] * c[3] + v1[2] * s[3]) * sc);
    return w;
}
__device__ __forceinline__ u32x4 plain_pack(f32x4 v0, f32x4 v1) { u32x4 w; w.x = cvt_pk_bf16(v0[0], v0[1]); w.y = cvt_pk_bf16(v0[2], v0[3]); w.z = cvt_pk_bf16(v1[0], v1[1]); w.w = cvt_pk_bf16(v1[2], v1[3]); return w; }

struct EpiDA {
    static constexpr bool PERM = true, AFTER_DRAIN = false;
    bf16_t* big; const float* tcos; const float* tsin;
    __device__ __forceinline__ void operator()(const f32x4 (&acc)[2][2][4][2], const Unit& u, int wr, int wc, int fr, int fq) const {
        const int region = u.pn >> 3; bf16_t* base = big + (size_t)region * ((size_t)MR * 2048);
        const int colr0 = (u.pn & 7) * 256 + wc * 32 + 8 * fq, row0 = u.pm * 256 + wr * 64 + fr;
        if (region < 2) {
            const int i0 = (colr0 & 127) >> 1; const float sc = region == 0 ? 0.08838834764831845f : 1.0f;
            f32x4 cs[8], sn[8];
#pragma unroll
            for (int q = 0; q < 8; ++q) { const int pos = (row0 + (q >> 2) * 128 + (q & 3) * 16) & (SEQ - 1); cs[q] = *(const f32x4*)(tcos + pos * 64 + i0); sn[q] = *(const f32x4*)(tsin + pos * 64 + i0); }
            asm volatile("" ::: "memory");
#pragma unroll
            for (int q = 0; q < 8; ++q) { const int ai = q >> 2, m = q & 3, row = row0 + ai * 128 + m * 16; const f32x4 c = cs[q], s = sn[q];
#pragma unroll
                for (int bj = 0; bj < 2; ++bj) { const f32x4 v0 = acc[ai][bj][m][0], v1 = acc[ai][bj][m][1]; u32x4 w;
                    w.x = cvt_pk_bf16((v0[0] * c[0] - v0[1] * s[0]) * sc, (v0[1] * c[0] + v0[0] * s[0]) * sc);
                    w.y = cvt_pk_bf16((v0[2] * c[1] - v0[3] * s[1]) * sc, (v0[3] * c[1] + v0[2] * s[1]) * sc);
                    w.z = cvt_pk_bf16((v1[0] * c[2] - v1[1] * s[2]) * sc, (v1[1] * c[2] + v1[0] * s[2]) * sc);
                    w.w = cvt_pk_bf16((v1[2] * c[3] - v1[3] * s[3]) * sc, (v1[3] * c[3] + v1[2] * s[3]) * sc);
                    *(u32x4*)(base + (size_t)row * 2048 + colr0 + bj * 128) = w; } }
        } else {
#pragma unroll
            for (int ai = 0; ai < 2; ++ai)
#pragma unroll
                for (int m = 0; m < 4; ++m) { const int row = row0 + ai * 128 + m * 16;
#pragma unroll
                    for (int bj = 0; bj < 2; ++bj) *(u32x4*)(base + (size_t)row * 2048 + colr0 + bj * 128) = plain_pack(acc[ai][bj][m][0], acc[ai][bj][m][1]); }
        }
    }
};
struct EpiRET {
    static constexpr bool PERM = true, AFTER_DRAIN = false;
    bf16_t* rq; bf16_t* rk; bf16_t* rv; bf16_t* rg; const float* tcos; const float* tsin;
    __device__ __forceinline__ void operator()(const f32x4 (&acc)[2][2][4][2], const Unit& u, int wr, int wc, int fr, int fq) const {
        const bool isrot = u.pn < 8; bf16_t* base; int ld, colt;
        if (u.pn < 4) { base = rq; ld = 1024; colt = u.pn * 256; } else if (u.pn < 8) { base = rk; ld = 1024; colt = (u.pn - 4) * 256; }
        else if (u.pn < 16) { base = rv; ld = 2048; colt = (u.pn - 8) * 256; } else { base = rg; ld = 2048; colt = (u.pn - 16) * 256; }
        const int colr0 = colt + wc * 32 + 8 * fq, row0 = u.pm * 256 + wr * 64 + fr;
        if (isrot) {
            const int i0 = (colr0 & 127) >> 1; const float sc = u.pn >= 4 ? 0.08838834764831845f : 1.0f;
            f32x4 cs[8], sn[8];
#pragma unroll
            for (int q = 0; q < 8; ++q) { const int pos = (row0 + (q >> 2) * 128 + (q & 3) * 16) & (SEQ - 1); cs[q] = *(const f32x4*)(tcos + pos * 64 + i0); sn[q] = *(const f32x4*)(tsin + pos * 64 + i0); }
            asm volatile("" ::: "memory");
#pragma unroll
            for (int q = 0; q < 8; ++q) { const int ai = q >> 2, m = q & 3, row = row0 + ai * 128 + m * 16; const f32x4 c = cs[q], s = sn[q];
#pragma unroll
                for (int bj = 0; bj < 2; ++bj) { const f32x4 v0 = acc[ai][bj][m][0], v1 = acc[ai][bj][m][1]; u32x4 w;
                    w.x = cvt_pk_bf16((v0[0] * c[0] - v0[1] * s[0]) * sc, (v0[1] * c[0] + v0[0] * s[0]) * sc);
                    w.y = cvt_pk_bf16((v0[2] * c[1] - v0[3] * s[1]) * sc, (v0[3] * c[1] + v0[2] * s[1]) * sc);
                    w.z = cvt_pk_bf16((v1[0] * c[2] - v1[1] * s[2]) * sc, (v1[1] * c[2] + v1[0] * s[2]) * sc);
                    w.w = cvt_pk_bf16((v1[2] * c[3] - v1[3] * s[3]) * sc, (v1[3] * c[3] + v1[2] * s[3]) * sc);
                    *(u32x4*)(base + (size_t)row * ld + colr0 + bj * 128) = w; } }
        } else {
#pragma unroll
            for (int ai = 0; ai < 2; ++ai)
#pragma unroll
                for (int m = 0; m < 4; ++m) { const int row = row0 + ai * 128 + m * 16;
#pragma unroll
                    for (int bj = 0; bj < 2; ++bj) *(u32x4*)(base + (size_t)row * ld + colr0 + bj * 128) = plain_pack(acc[ai][bj][m][0], acc[ai][bj][m][1]); }
        }
    }
};
struct EpiRes {
    static constexpr bool PERM = false, AFTER_DRAIN = false;
    float* out; const float* res;
    __device__ __forceinline__ void operator()(const f32x4 (&acc)[2][2][4][2], const Unit& u, int wr, int wc, int fr, int fq) const {
        const int row0 = u.pm * 256 + wr * 64 + fr, col0 = u.pn * 256 + wc * 32 + 4 * fq;
#pragma unroll
        for (int ai = 0; ai < 2; ++ai) {
            f32x4 r[4][2][2];
#pragma unroll
            for (int m = 0; m < 4; ++m)
#pragma unroll
                for (int bj = 0; bj < 2; ++bj)
#pragma unroll
                    for (int n = 0; n < 2; ++n) r[m][bj][n] = *(const f32x4*)(res + (size_t)(row0 + ai * 128 + m * 16) * DM + col0 + bj * 128 + n * 16);
            asm volatile("" ::: "memory");
#pragma unroll
            for (int m = 0; m < 4; ++m)
#pragma unroll
                for (int bj = 0; bj < 2; ++bj)
#pragma unroll
                    for (int n = 0; n < 2; ++n) *(f32x4*)(out + (size_t)(row0 + ai * 128 + m * 16) * DM + col0 + bj * 128 + n * 16) = acc[ai][bj][m][n] + r[m][bj][n];
        }
    }
};
struct EpiDelta {
    static constexpr bool PERM = true, AFTER_DRAIN = false;
    bf16_t* D;
    __device__ __forceinline__ void operator()(const f32x4 (&acc)[2][2][4][2], const Unit& u, int wr, int wc, int fr, int fq) const {
        const int colr0 = u.pn * 256 + wc * 32 + 8 * fq, row0 = u.pm * 256 + wr * 64 + fr;
#pragma unroll
        for (int ai = 0; ai < 2; ++ai)
#pragma unroll
            for (int m = 0; m < 4; ++m) { const int row = row0 + ai * 128 + m * 16;
#pragma unroll
                for (int bj = 0; bj < 2; ++bj) *(u32x4*)(D + (size_t)row * DM + colr0 + bj * 128) = plain_pack(acc[ai][bj][m][0], acc[ai][bj][m][1]); }
    }
};
template <class Epi> __device__ __forceinline__ void run_gemm(LAS unsigned char* lds, const bf16_t* A, const bf16_t* Bt, int M, int N, int K, const Epi& E) {
    Gemm g; g.A = A; g.Bt = Bt; g.M = M; g.N = N; g.K = K;
    StaticOrder S; S.init(M, N, (int)gridDim.x, (int)blockIdx.x);
    pg8::gemm_phase<Epi, StaticOrder, false>(lds, g, S, E, nullptr);
}

__device__ __forceinline__ void subln_gate_store(LAS unsigned char* lds, const float* __restrict__ g, float oscale, const bf16_t* __restrict__ gate, bf16_t* __restrict__ dst, int ld) {
    const int tid_ = mk_opaque_tid(), wid = tid_ >> 6, lane = tid_ & 63, cc = lane & 31;
    f32x4 g0 = *(const f32x4*)(g + cc * 8), g1 = *(const f32x4*)(g + cc * 8 + 4);
    u32x4 gt[8];
#pragma unroll
    for (int j = 0; j < 8; ++j) gt[j] = *(const u32x4*)(gate + (size_t)(16 * wid + 2 * j + (lane >> 5)) * ld + cc * 8);
    asm volatile("" ::: "memory");
#pragma unroll
    for (int j = 0; j < 8; ++j) {
        const int row = 16 * wid + 2 * j + (lane >> 5);
        const f32x4 a = *(const LAS f32x4*)(lds + (row * 256 + cc * 8) * 4), b = *(const LAS f32x4*)(lds + (row * 256 + cc * 8 + 4) * 4);
        float ss = a[0] * a[0] + a[1] * a[1] + a[2] * a[2] + a[3] * a[3] + b[0] * b[0] + b[1] * b[1] + b[2] * b[2] + b[3] * b[3];
#pragma unroll
        for (int o = 16; o >= 1; o >>= 1) ss += __shfl_xor(ss, o);
        const float rs = rsqrtf(ss * (1.0f / 256.0f) + 1e-5f) * oscale;
        float gg[8] = {bflo(gt[j].x), bfhi(gt[j].x), bflo(gt[j].y), bfhi(gt[j].y), bflo(gt[j].z), bfhi(gt[j].z), bflo(gt[j].w), bfhi(gt[j].w)};
        float y[8] = {a[0] * g0[0], a[1] * g0[1], a[2] * g0[2], a[3] * g0[3], b[0] * g1[0], b[1] * g1[1], b[2] * g1[2], b[3] * g1[3]};
#pragma unroll
        for (int e2 = 0; e2 < 8; ++e2) { const float sg = gg[e2] * __builtin_amdgcn_rcpf(1.0f + __expf(-gg[e2])); y[e2] = y[e2] * rs * sg; }
        u32x4 w; w.x = cvt_pk_bf16(y[0], y[1]); w.y = cvt_pk_bf16(y[2], y[3]); w.z = cvt_pk_bf16(y[4], y[5]); w.w = cvt_pk_bf16(y[6], y[7]);
        *(u32x4*)(dst + (size_t)row * ld + cc * 8) = w;
    }
}

constexpr float LOG2E = 1.4426950408889634f, ATHR = 8.0f;
__device__ __forceinline__ void partialSM(f32x16& p0, f32x16& p1, float& m_reg, float& mn, float& alpha) {
    float pmax = p0[0];
#pragma unroll
    for (int r = 1; r < 16; ++r) pmax = fmaxf(pmax, p0[r]);
#pragma unroll
    for (int r = 0; r < 16; ++r) pmax = fmaxf(pmax, p1[r]);
    { auto rr = __builtin_amdgcn_permlane32_swap(__float_as_uint(pmax), __float_as_uint(pmax), false, false); pmax = fmaxf(__uint_as_float(rr[0]), __uint_as_float(rr[1])); }
    if (__builtin_expect(__all(pmax - m_reg <= ATHR), 1)) { mn = m_reg; alpha = 1.f; }
    else { mn = fmaxf(m_reg, pmax); alpha = __builtin_amdgcn_exp2f((m_reg - mn) * LOG2E); m_reg = mn; }
    const float mnC = -mn * LOG2E;
#pragma unroll
    for (int r = 0; r < 16; ++r) p0[r] = __builtin_amdgcn_exp2f(fmaf(p0[r], LOG2E, mnC));
#pragma unroll
    for (int r = 0; r < 16; ++r) p1[r] = __builtin_amdgcn_exp2f(fmaf(p1[r], LOG2E, mnC));
}
__device__ __forceinline__ void finishSM(f32x16& p0, f32x16& p1, float alpha, float& l_reg, bf16x8& pa0, bf16x8& pa1, bf16x8& pa2, bf16x8& pa3) {
    float ps = 0;
#pragma unroll
    for (int r = 0; r < 16; ++r) ps += p0[r];
#pragma unroll
    for (int r = 0; r < 16; ++r) ps += p1[r];
    { auto rr = __builtin_amdgcn_permlane32_swap(__float_as_uint(ps), __float_as_uint(ps), false, false); ps = __uint_as_float(rr[0]) + __uint_as_float(rr[1]); }
    l_reg = l_reg * alpha + ps;
    PK4(p0, 0, pa0); PK4(p0, 8, pa1); PK4(p1, 0, pa2); PK4(p1, 8, pa3);
}
template <int D0> __device__ __forceinline__ void pv_one(f32x16& od, unsigned vb, bf16x8 pa0, bf16x8 pa1, bf16x8 pa2, bf16x8 pa3) {
    const s16x4 l0 = tr_read<D0 * 512 + 0 * 8192>(vb), h0 = tr_read<D0 * 512 + 0 * 8192 + 4096>(vb), l1 = tr_read<D0 * 512 + 1 * 8192>(vb), h1 = tr_read<D0 * 512 + 1 * 8192 + 4096>(vb);
    const s16x4 l2 = tr_read<D0 * 512 + 2 * 8192>(vb), h2 = tr_read<D0 * 512 + 2 * 8192 + 4096>(vb), l3 = tr_read<D0 * 512 + 3 * 8192>(vb), h3 = tr_read<D0 * 512 + 3 * 8192 + 4096>(vb);
    asm volatile("s_waitcnt lgkmcnt(0)" ::: "memory"); SBAR();
    od = __builtin_amdgcn_mfma_f32_32x32x16_bf16(pa0, PKLH(l0, h0), od, 0, 0, 0);
    od = __builtin_amdgcn_mfma_f32_32x32x16_bf16(pa1, PKLH(l1, h1), od, 0, 0, 0);
    od = __builtin_amdgcn_mfma_f32_32x32x16_bf16(pa2, PKLH(l2, h2), od, 0, 0, 0);
    od = __builtin_amdgcn_mfma_f32_32x32x16_bf16(pa3, PKLH(l3, h3), od, 0, 0, 0);
}

#define SBV() __builtin_amdgcn_sched_barrier(0x2 | 0x4 | 0x400)
__device__ __forceinline__ void smA(f32x16& p0, f32x16& p1, float& m_reg, float& alpha) {
    float pmax = p0[0];
#pragma unroll
    for (int r = 1; r < 16; ++r) pmax = fmaxf(pmax, p0[r]);
#pragma unroll
    for (int r = 0; r < 16; ++r) pmax = fmaxf(pmax, p1[r]);
    { auto rr = __builtin_amdgcn_permlane32_swap(__float_as_uint(pmax), __float_as_uint(pmax), false, false); pmax = fmaxf(__uint_as_float(rr[0]), __uint_as_float(rr[1])); }
    float mn;
    if (__builtin_expect(__all(pmax - m_reg <= ATHR), 1)) { mn = m_reg; alpha = 1.f; }
    else { mn = fmaxf(m_reg, pmax); alpha = __builtin_amdgcn_exp2f((m_reg - mn) * LOG2E); m_reg = mn; }
    const float mnC = -mn * LOG2E;
#pragma unroll
    for (int r = 0; r < 16; ++r) p0[r] = __builtin_amdgcn_exp2f(fmaf(p0[r], LOG2E, mnC));
#pragma unroll
    for (int r = 0; r < 16; ++r) p1[r] = fmaf(p1[r], LOG2E, mnC);
}
template <int D0, int KS0> __device__ __forceinline__ void pv_half(f32x16& oa, f32x16& ob, unsigned vb, bf16x8 paX, bf16x8 paY) {
    const s16x4 l0 = tr_read<D0 * 512 + KS0 * 8192>(vb), h0 = tr_read<D0 * 512 + KS0 * 8192 + 4096>(vb), l1 = tr_read<D0 * 512 + (KS0 + 1) * 8192>(vb), h1 = tr_read<D0 * 512 + (KS0 + 1) * 8192 + 4096>(vb);
    const s16x4 m0 = tr_read<(D0 + 1) * 512 + KS0 * 8192>(vb), n0 = tr_read<(D0 + 1) * 512 + KS0 * 8192 + 4096>(vb), m1 = tr_read<(D0 + 1) * 512 + (KS0 + 1) * 8192>(vb), n1 = tr_read<(D0 + 1) * 512 + (KS0 + 1) * 8192 + 4096>(vb);
    asm volatile("s_waitcnt lgkmcnt(0)" ::: "memory"); SBV();
    oa = __builtin_amdgcn_mfma_f32_32x32x16_bf16(paX, PKLH(l0, h0), oa, 0, 0, 0);
    oa = __builtin_amdgcn_mfma_f32_32x32x16_bf16(paY, PKLH(l1, h1), oa, 0, 0, 0);
    ob = __builtin_amdgcn_mfma_f32_32x32x16_bf16(paX, PKLH(m0, n0), ob, 0, 0, 0);
    ob = __builtin_amdgcn_mfma_f32_32x32x16_bf16(paY, PKLH(m1, n1), ob, 0, 0, 0);
}
__device__ __forceinline__ void attn_phase(const Params& P, LAS unsigned char* lds) {
    constexpr int NT = SEQ / 64;
    for (int it = blockIdx.x; it < GSEQ * 8 * 32; it += gridDim.x) {
        const int tid = mk_opaque_tid(), wid = __builtin_amdgcn_readfirstlane(tid >> 6), lane = tid & 63, r32 = lane & 31, hi = lane >> 5;
        const int map = wid >> 2, wq = wid & 3;
        bf16_t* qbuf = (bf16_t*)(P.ws + OFF_BIG); const bf16_t* kbuf = qbuf + (size_t)MR * 2048; const bf16_t* vbuf = kbuf + (size_t)MR * 2048; const bf16_t* gbuf = vbuf + (size_t)MR * 2048;
        const unsigned lds0 = (unsigned)(size_t)lds;
        LAS float* li_l = (LAS float*)(lds + 131072 + wid * 256); LAS float* al_l = li_l + 32;
        const unsigned kL = (unsigned)((4 * wid + (lane >> 4)) * 2048 + (((lane & 15) ^ (4 * (wid & 1) + (lane >> 4))) * 8)) * 2u;
        const unsigned vL = (unsigned)((8 * ((lane >> 4) & 1) + 4 * (wid >> 2) + ((lane >> 2) & 3)) * 2048 + (2 * (wid & 3) + (lane >> 5)) * 32 + (lane & 3) * 8) * 2u;
        const int head = it & 7, qblk = (it >> 3) & 31, seq = it >> 8;
        const size_t tok0 = (size_t)seq * SEQ;
        const char* kb = (const char*)(kbuf + tok0 * 2048 + (2 * head) * 128);
        const char* vb = (const char*)(vbuf + tok0 * 2048 + head * 256);
#define AT_PIECE(i, sbase, ko_, vo_) do { \
        if ((i) == 0) __builtin_amdgcn_global_load_lds((const unsigned*)(kb + (ko_)), (LAS unsigned*)(sbase), 16, 0, 2); \
        if ((i) == 1) __builtin_amdgcn_global_load_lds((const unsigned*)(kb + ((ko_) + 32u * 4096u)), (LAS unsigned*)((sbase) + 8192), 16, 0, 2); \
        if ((i) == 2) __builtin_amdgcn_global_load_lds((const unsigned*)(kb + ((ko_) + 256u)), (LAS unsigned*)((sbase) + 16384), 16, 0, 2); \
        if ((i) == 3) __builtin_amdgcn_global_load_lds((const unsigned*)(kb + ((ko_) + 256u + 32u * 4096u)), (LAS unsigned*)((sbase) + 16384 + 8192), 16, 0, 2); \
        if ((i) == 4) __builtin_amdgcn_global_load_lds((const unsigned*)(vb + (vo_)), (LAS unsigned*)((sbase) + 32768), 16, 0, 2); \
        if ((i) == 5) __builtin_amdgcn_global_load_lds((const unsigned*)(vb + ((vo_) + 16u * 4096u)), (LAS unsigned*)((sbase) + 32768 + 8192), 16, 0, 2); \
        if ((i) == 6) __builtin_amdgcn_global_load_lds((const unsigned*)(vb + ((vo_) + 32u * 4096u)), (LAS unsigned*)((sbase) + 32768 + 16384), 16, 0, 2); \
        if ((i) == 7) __builtin_amdgcn_global_load_lds((const unsigned*)(vb + ((vo_) + 48u * 4096u)), (LAS unsigned*)((sbase) + 32768 + 24576), 16, 0, 2); } while (0)
#define AT_ISSUE(st, k0) do { LAS unsigned char* s_ = lds + (st) * 65536 + wid * 1024; const unsigned ko_ = kL + (unsigned)(k0) * 4096u, vo_ = vL + (unsigned)(k0) * 4096u; \
        AT_PIECE(0, s_, ko_, vo_); AT_PIECE(1, s_, ko_, vo_); AT_PIECE(2, s_, ko_, vo_); AT_PIECE(3, s_, ko_, vo_); AT_PIECE(4, s_, ko_, vo_); AT_PIECE(5, s_, ko_, vo_); AT_PIECE(6, s_, ko_, vo_); AT_PIECE(7, s_, ko_, vo_); } while (0)
        const size_t qrow0 = tok0 + qblk * 128;
        bf16x8 qr[8];
        { const bf16_t* qp = qbuf + (qrow0 + wq * 32 + r32) * 2048 + (2 * head + map) * 128 + hi * 8;
#pragma unroll
          for (int d0 = 0; d0 < 8; ++d0) qr[d0] = *(const bf16x8*)(qp + d0 * 16); }
        AT_ISSUE(0, 0);
        asm volatile("s_waitcnt vmcnt(0)" ::: "memory"); MK_BAR();
        float m_reg = -1e30f, l_reg = 0.f; f32x16 o[8];
#pragma unroll
        for (int d = 0; d < 8; ++d) o[d] = f32x16{};
        for (int j = 0; j < NT; ++j) {
            const unsigned st = (unsigned)(j & 1) * 65536u;
            f32x16 p0 = f32x16{}, p1 = f32x16{};
            { const LAS unsigned char* Ks = lds + st + map * 16384;
              const bool more = j + 1 < NT;
              LAS unsigned char* sn_ = lds + (65536u - st) + wid * 1024; const unsigned kon_ = kL + (unsigned)(j + 1) * (64u * 4096u), von_ = vL + (unsigned)(j + 1) * (64u * 4096u);
#pragma unroll
              for (int d0 = 0; d0 < 8; ++d0) { const int cb = (d0 * 16 + hi * 8) * 2;
                  const bf16x8 b0 = *(const LAS bf16x8*)(Ks + KSWZ(r32, cb)); const bf16x8 b1 = *(const LAS bf16x8*)(Ks + 8192 + KSWZ(r32, cb));
                  p0 = __builtin_amdgcn_mfma_f32_32x32x16_bf16(b0, qr[d0], p0, 0, 0, 0);
                  p1 = __builtin_amdgcn_mfma_f32_32x32x16_bf16(b1, qr[d0], p1, 0, 0, 0);
                  if (more) AT_PIECE(d0, sn_, kon_, von_);
                  SBAR(); } }
            float al; smA(p0, p1, m_reg, al);
            if (__any(al < 1.f)) { if (hi == 0) al_l[r32] = al; asm volatile("s_waitcnt lgkmcnt(0)" ::: "memory");
#pragma unroll
                for (int r = 0; r < 16; ++r) { const float a = al_l[crow(r, hi)];
#pragma unroll
                    for (int d = 0; d < 8; ++d) o[d][r] *= a; } }
            bf16x8 pa0, pa1, pa2, pa3; float ps = 0.f;
#pragma unroll
            for (int r = 0; r < 16; ++r) ps += p0[r];
            PK4(p0, 0, pa0); PK4(p0, 8, pa1);
            const unsigned vb0 = lds0 + st + 32768u + (unsigned)v_rd_base(lane);
#define PVR(G, D0, KS0) const s16x4 G##l0 = tr_read<(D0) * 512 + (KS0) * 8192>(vb0), G##h0 = tr_read<(D0) * 512 + (KS0) * 8192 + 4096>(vb0), G##l1 = tr_read<(D0) * 512 + ((KS0) + 1) * 8192>(vb0), G##h1 = tr_read<(D0) * 512 + ((KS0) + 1) * 8192 + 4096>(vb0), \
                G##m0 = tr_read<((D0) + 1) * 512 + (KS0) * 8192>(vb0), G##n0 = tr_read<((D0) + 1) * 512 + (KS0) * 8192 + 4096>(vb0), G##m1 = tr_read<((D0) + 1) * 512 + ((KS0) + 1) * 8192>(vb0), G##n1 = tr_read<((D0) + 1) * 512 + ((KS0) + 1) * 8192 + 4096>(vb0)
#define PVM(G, OA, OB, PX, PY) do { asm volatile("s_waitcnt lgkmcnt(0)" ::: "memory"); SBAR(); \
                OA = __builtin_amdgcn_mfma_f32_32x32x16_bf16(PX, PKLH(G##l0, G##h0), OA, 0, 0, 0); OA = __builtin_amdgcn_mfma_f32_32x32x16_bf16(PY, PKLH(G##l1, G##h1), OA, 0, 0, 0); \
                OB = __builtin_amdgcn_mfma_f32_32x32x16_bf16(PX, PKLH(G##m0, G##n0), OB, 0, 0, 0); OB = __builtin_amdgcn_mfma_f32_32x32x16_bf16(PY, PKLH(G##m1, G##n1), OB, 0, 0, 0); } while (0)
            PVR(ga, 0, 0);
            PVM(ga, o[0], o[1], pa0, pa1); PVR(gb, 2, 0);
#pragma unroll
            for (int r = 0; r < 4; ++r) { p1[r] = __builtin_amdgcn_exp2f(p1[r]); ps += p1[r]; }
            PVM(gb, o[2], o[3], pa0, pa1); PVR(gc, 4, 0);
#pragma unroll
            for (int r = 4; r < 8; ++r) { p1[r] = __builtin_amdgcn_exp2f(p1[r]); ps += p1[r]; }
            PK4(p1, 0, pa2);
            PVM(gc, o[4], o[5], pa0, pa1); PVR(gd, 6, 0);
#pragma unroll
            for (int r = 8; r < 12; ++r) { p1[r] = __builtin_amdgcn_exp2f(p1[r]); ps += p1[r]; }
            PVM(gd, o[6], o[7], pa0, pa1); PVR(ge, 0, 2);
#pragma unroll
            for (int r = 12; r < 16; ++r) { p1[r] = __builtin_amdgcn_exp2f(p1[r]); ps += p1[r]; }
            PK4(p1, 8, pa3);
            { auto rr = __builtin_amdgcn_permlane32_swap(__float_as_uint(ps), __float_as_uint(ps), false, false); ps = __uint_as_float(rr[0]) + __uint_as_float(rr[1]); }
            l_reg = l_reg * al + ps;
            PVM(ge, o[0], o[1], pa2, pa3); PVR(gf, 2, 2);
            PVM(gf, o[2], o[3], pa2, pa3); PVR(gg, 4, 2);
            PVM(gg, o[4], o[5], pa2, pa3); PVR(gh, 6, 2);
            PVM(gh, o[6], o[7], pa2, pa3);
#undef PVR
#undef PVM
            asm volatile("s_waitcnt vmcnt(0)" ::: "memory"); MK_BAR();
        }
#undef AT_ISSUE
#undef AT_PIECE
        float lam;
        { float a = P.lq1[lane] * P.lk1[lane] + P.lq1[lane + 64] * P.lk1[lane + 64], b = P.lq2[lane] * P.lk2[lane] + P.lq2[lane + 64] * P.lk2[lane + 64];
    #pragma unroll
          for (int o = 32; o >= 1; o >>= 1) { a += __shfl_xor(a, o); b += __shfl_xor(b, o); }
          lam = __expf(a) - __expf(b) + 0.2f; }
        if (hi == 0) li_l[r32] = l_reg; asm volatile("s_waitcnt lgkmcnt(0)" ::: "memory");
        LAS unsigned char* reg = lds + wq * 32768;
        if (map == 1) {
#pragma unroll
            for (int r = 0; r < 16; ++r) { const float s = lam * __builtin_amdgcn_rcpf(li_l[crow(r, hi)]);
#pragma unroll
                for (int d = 0; d < 8; ++d) *(LAS float*)(reg + ((d * 16 + r) * 64 + lane) * 4) = o[d][r] * s; }
        }
        MK_BAR();
        if (map == 0) {
#pragma unroll
            for (int r = 0; r < 16; ++r) { const float s = __builtin_amdgcn_rcpf(li_l[crow(r, hi)]);
#pragma unroll
                for (int d = 0; d < 8; ++d) o[d][r] = o[d][r] * s - *(const LAS float*)(reg + ((d * 16 + r) * 64 + lane) * 4); }
            asm volatile("s_waitcnt lgkmcnt(0)" ::: "memory");
#pragma unroll
            for (int r = 0; r < 16; ++r)
#pragma unroll
                for (int d = 0; d < 8; ++d) *(LAS float*)(reg + (crow(r, hi) * 256 + d * 32 + r32) * 4) = o[d][r];
        }
        MK_BAR();
        subln_gate_store(lds, P.da_subln_g, 0.8f, gbuf + qrow0 * 2048 + head * 256, qbuf + qrow0 * 2048 + head * 256, 2048);
        MK_BAR();
    }
}

__device__ __forceinline__ void ret_chain_phase(const Params& P, LAS unsigned char* lds) {
    const int tid = mk_opaque_tid(), wid = __builtin_amdgcn_readfirstlane(tid >> 6), lane = tid & 63, r32 = lane & 31, hi = lane >> 5;
    const int sr = tid >> 4, sc = (tid & 15) * 8, m0 = wid & 3, nb0 = 2 * (wid >> 2);
    const bf16_t* rk = (const bf16_t*)(P.ws + OFF_RK); const bf16_t* rv = (const bf16_t*)(P.ws + OFF_RV);
    const unsigned lds0 = (unsigned)(size_t)lds;
    const unsigned abase = lds0 + (unsigned)v_rd_base(lane) + (unsigned)m0 * 512u, bbase = lds0 + 32768u + (unsigned)v_rd_base(lane) + (unsigned)nb0 * 512u;
    for (int cid = blockIdx.x; cid < GSEQ * 8 * 4; cid += gridDim.x) {
        const int dvh = cid & 1, dir = (cid >> 1) & 1, head = (cid >> 2) & 7, seq = cid >> 5;
        const float lg = -__expf((dir ? P.ret_decay_bwd : P.ret_decay_fwd)[head]) * LOG2E;
        const float cdec = __builtin_amdgcn_exp2f(128.f * lg);
        const bf16_t* kb = rk + (size_t)seq * SEQ * 1024 + head * 128 + sc;
        const bf16_t* vb = rv + (size_t)seq * SEQ * 2048 + head * 256 + dvh * 128 + sc;
        bf16_t* Sbase = (bf16_t*)(P.ws + (dir ? OFF_SB : OFF_SF)) + (size_t)((seq * 8 + head) * 32) * 32768;
        f32x16 acc[2]; acc[0] = f32x16{}; acc[1] = f32x16{};
        bf16x8 kreg[4], vreg[4];
        int c = dir ? 31 : 0;
#pragma unroll
        for (int i = 0; i < 4; ++i) { kreg[i] = __builtin_nontemporal_load((const bf16x8*)(kb + (size_t)(c * 128 + sr + 32 * i) * 1024)); vreg[i] = __builtin_nontemporal_load((const bf16x8*)(vb + (size_t)(c * 128 + sr + 32 * i) * 2048)); }
#define CH_STORE(cc_) do { bf16_t* Sc = Sbase + (size_t)(cc_) * 32768; \
            _Pragma("unroll") for (int nb = 0; nb < 2; ++nb) _Pragma("unroll") for (int q4 = 0; q4 < 4; ++q4) { const int dv = dvh * 128 + 32 * (nb0 + nb) + r32, dk = 32 * m0 + 8 * q4 + 4 * hi; \
                uint2 w; w.x = cvt_pk_bf16(acc[nb][4 * q4 + 0], acc[nb][4 * q4 + 1]); w.y = cvt_pk_bf16(acc[nb][4 * q4 + 2], acc[nb][4 * q4 + 3]); *(uint2*)(Sc + dv * 128 + dk) = w; } } while (0)
        CH_STORE(c);
        for (int s = 0; s < 31; ++s) {
#pragma unroll
            for (int i = 0; i < 4; ++i) { const int j = sr + 32 * i; const float f = __builtin_amdgcn_exp2f(lg * (float)(dir ? j : 127 - j));
                *(LAS bf16x8*)(lds + v_st<4>(j, sc)) = scale8(kreg[i], f); *(LAS bf16x8*)(lds + 32768 + v_st<4>(j, sc)) = vreg[i]; }
            const int cn = dir ? c - 1 : c + 1;
            if (s + 1 < 31) {
#pragma unroll
                for (int i = 0; i < 4; ++i) { kreg[i] = __builtin_nontemporal_load((const bf16x8*)(kb + (size_t)(cn * 128 + sr + 32 * i) * 1024)); vreg[i] = __builtin_nontemporal_load((const bf16x8*)(vb + (size_t)(cn * 128 + sr + 32 * i) * 2048)); } }
            __syncthreads();
#pragma unroll
            for (int r = 0; r < 16; ++r) { acc[0][r] *= cdec; acc[1][r] *= cdec; }
#define CH_STEP(KS) do { const s16x4 al_ = tr_read<(KS) * 4096>(abase), ah_ = tr_read<(KS) * 4096 + 2048>(abase); \
                const s16x4 b0l_ = tr_read<(KS) * 4096>(bbase), b0h_ = tr_read<(KS) * 4096 + 2048>(bbase), b1l_ = tr_read<512 + (KS) * 4096>(bbase), b1h_ = tr_read<512 + (KS) * 4096 + 2048>(bbase); \
                asm volatile("s_waitcnt lgkmcnt(0)" ::: "memory"); SBAR(); \
                acc[0] = __builtin_amdgcn_mfma_f32_32x32x16_bf16(PKLH(al_, ah_), PKLH(b0l_, b0h_), acc[0], 0, 0, 0); \
                acc[1] = __builtin_amdgcn_mfma_f32_32x32x16_bf16(PKLH(al_, ah_), PKLH(b1l_, b1h_), acc[1], 0, 0, 0); } while (0)
            CH_STEP(0); CH_STEP(1); CH_STEP(2); CH_STEP(3); CH_STEP(4); CH_STEP(5); CH_STEP(6); CH_STEP(7);
#undef CH_STEP
            __syncthreads();
            c = cn;
            CH_STORE(c);
        }
#undef CH_STORE
    }
}

template <int D0> __device__ __forceinline__ void ro_pv(f32x16& od, unsigned vb, const bf16x8 (&pa)[8]) {
    const s16x4 l0 = tr_read<D0 * 512 + 0 * 8192>(vb), h0 = tr_read<D0 * 512 + 0 * 8192 + 4096>(vb), l1 = tr_read<D0 * 512 + 1 * 8192>(vb), h1 = tr_read<D0 * 512 + 1 * 8192 + 4096>(vb);
    const s16x4 l2 = tr_read<D0 * 512 + 2 * 8192>(vb), h2 = tr_read<D0 * 512 + 2 * 8192 + 4096>(vb), l3 = tr_read<D0 * 512 + 3 * 8192>(vb), h3 = tr_read<D0 * 512 + 3 * 8192 + 4096>(vb);
    const s16x4 l4 = tr_read<D0 * 512 + 4 * 8192>(vb), h4 = tr_read<D0 * 512 + 4 * 8192 + 4096>(vb), l5 = tr_read<D0 * 512 + 5 * 8192>(vb), h5 = tr_read<D0 * 512 + 5 * 8192 + 4096>(vb);
    const s16x4 l6 = tr_read<D0 * 512 + 6 * 8192>(vb), h6 = tr_read<D0 * 512 + 6 * 8192 + 4096>(vb), l7 = tr_read<D0 * 512 + 7 * 8192>(vb), h7 = tr_read<D0 * 512 + 7 * 8192 + 4096>(vb);
    asm volatile("s_waitcnt lgkmcnt(0)" ::: "memory"); SBAR();
    od = __builtin_amdgcn_mfma_f32_32x32x16_bf16(pa[0], PKLH(l0, h0), od, 0, 0, 0); od = __builtin_amdgcn_mfma_f32_32x32x16_bf16(pa[1], PKLH(l1, h1), od, 0, 0, 0);
    od = __builtin_amdgcn_mfma_f32_32x32x16_bf16(pa[2], PKLH(l2, h2), od, 0, 0, 0); od = __builtin_amdgcn_mfma_f32_32x32x16_bf16(pa[3], PKLH(l3, h3), od, 0, 0, 0);
    od = __builtin_amdgcn_mfma_f32_32x32x16_bf16(pa[4], PKLH(l4, h4), od, 0, 0, 0); od = __builtin_amdgcn_mfma_f32_32x32x16_bf16(pa[5], PKLH(l5, h5), od, 0, 0, 0);
    od = __builtin_amdgcn_mfma_f32_32x32x16_bf16(pa[6], PKLH(l6, h6), od, 0, 0, 0); od = __builtin_amdgcn_mfma_f32_32x32x16_bf16(pa[7], PKLH(l7, h7), od, 0, 0, 0);
}
__device__ __forceinline__ void ret_out_phase(const Params& P, LAS unsigned char* lds) {
    for (int it = blockIdx.x; it < GSEQ * 8 * 32; it += gridDim.x) {
        const int tid = mk_opaque_tid(), wid = __builtin_amdgcn_readfirstlane(tid >> 6), lane = tid & 63, r32 = lane & 31, hi = lane >> 5;
        const int wq = wid & 3, wh = wid >> 2;
        const bf16_t* rq = (const bf16_t*)(P.ws + OFF_RQ); const bf16_t* rk = (const bf16_t*)(P.ws + OFF_RK); bf16_t* rv = (bf16_t*)(P.ws + OFF_RV); const bf16_t* rg = (const bf16_t*)(P.ws + OFF_RG);
        const bf16_t* SF = (const bf16_t*)(P.ws + OFF_SF); const bf16_t* SB = (const bf16_t*)(P.ws + OFF_SB);
        const unsigned lds0 = (unsigned)(size_t)lds;
        LAS unsigned char* bufA = lds; LAS unsigned char* bufB = lds + 65536;
        const int rowL = 4 * wid + (lane >> 4), chL = ((lane & 15) ^ (4 * (wid & 1) + (lane >> 4))) * 8;
        const unsigned kL = (unsigned)(rowL * 1024 + chL) * 2u, sL = (unsigned)(rowL * 128 + chL) * 2u;
        const unsigned vL = (unsigned)((8 * ((lane >> 4) & 1) + 4 * (wid >> 2) + ((lane >> 2) & 3)) * 2048 + (2 * (wid & 3) + (lane >> 5)) * 32 + (lane & 3) * 8) * 2u;
        const int chunk = it & 31, head = (it >> 5) & 7, seq = it >> 8;
        const size_t tokc = (size_t)seq * SEQ + chunk * 128;
        const float lgf = -__expf(P.ret_decay_fwd[head]) * LOG2E, lgb = -__expf(P.ret_decay_bwd[head]) * LOG2E;
        const char* SfT = (const char*)(SF + (size_t)((seq * 8 + head) * 32 + chunk) * 32768); const char* SbT = (const char*)(SB + (size_t)((seq * 8 + head) * 32 + chunk) * 32768);
        const char* kbp = (const char*)(rk + tokc * 1024 + head * 128); const char* vbp = (const char*)(rv + tokc * 2048 + head * 256);
#pragma unroll
        for (int i = 0; i < 4; ++i) __builtin_amdgcn_global_load_lds((const unsigned*)(kbp + (kL + (unsigned)i * (32u * 2048u))), (LAS unsigned*)(bufB + i * 8192 + wid * 1024), 16, 0, 2);
#pragma unroll
        for (int i = 0; i < 8; ++i) __builtin_amdgcn_global_load_lds((const unsigned*)(vbp + (vL + (unsigned)i * (16u * 4096u))), (LAS unsigned*)(bufA + i * 8192 + wid * 1024), 16, 0, 2);
        bf16x8 qr[8];
        { const bf16_t* qp = rq + (tokc + wq * 32 + r32) * 1024 + head * 128 + hi * 8;
#pragma unroll
          for (int d0 = 0; d0 < 8; ++d0) qr[d0] = *(const bf16x8*)(qp + d0 * 16); }
        asm volatile("s_waitcnt vmcnt(0)" ::: "memory"); MK_BAR();
        const int n = 32 * wq + r32;
        bf16x8 pa[8];
#pragma unroll
        for (int kb = 0; kb < 4; ++kb) { f32x16 p = f32x16{};
#pragma unroll
            for (int d0 = 0; d0 < 8; ++d0) { const bf16x8 a = *(const LAS bf16x8*)(bufB + kb * 8192 + KSWZ(r32, (d0 * 16 + hi * 8) * 2)); p = __builtin_amdgcn_mfma_f32_32x32x16_bf16(a, qr[d0], p, 0, 0, 0); }
#pragma unroll
            for (int r = 0; r < 16; ++r) { const int d = n - (32 * kb + crow(r, hi)); const float e = d >= 0 ? (float)d * lgf : (float)(-d) * lgb; p[r] *= __builtin_amdgcn_exp2f(e); }
            PK4(p, 0, pa[2 * kb]); PK4(p, 8, pa[2 * kb + 1]); SBAR(); }
        MK_BAR();
#pragma unroll
        for (int i = 0; i < 8; ++i) __builtin_amdgcn_global_load_lds((const unsigned*)(SfT + (sL + (unsigned)i * 8192u)), (LAS unsigned*)(bufB + i * 8192 + wid * 1024), 16, 0, 2);
        f32x16 o[4];
#pragma unroll
        for (int d = 0; d < 4; ++d) o[d] = f32x16{};
        { const unsigned vb0 = lds0 + (unsigned)v_rd_base(lane) + (unsigned)(4 * wh) * 512u;
          ro_pv<0>(o[0], vb0, pa); ro_pv<1>(o[1], vb0, pa); ro_pv<2>(o[2], vb0, pa); ro_pv<3>(o[3], vb0, pa); }
        MK_BAR();
#pragma unroll
        for (int i = 0; i < 8; ++i) __builtin_amdgcn_global_load_lds((const unsigned*)(SbT + (sL + (unsigned)i * 8192u)), (LAS unsigned*)(bufA + i * 8192 + wid * 1024), 16, 0, 2);
        asm volatile("s_waitcnt vmcnt(8)" ::: "memory"); MK_BAR();
        { const float qs = __builtin_amdgcn_exp2f(lgf * (float)(n + 1));
#pragma unroll
          for (int ks = 0; ks < 8; ++ks) { const bf16x8 qf = scale8(qr[ks], qs);
#pragma unroll
              for (int d0 = 0; d0 < 4; ++d0) { const bf16x8 b = *(const LAS bf16x8*)(bufB + (128 * wh + 32 * d0) * 256 + KSWZ(r32, (16 * ks + 8 * hi) * 2)); o[d0] = __builtin_amdgcn_mfma_f32_32x32x16_bf16(qf, b, o[d0], 0, 0, 0); } } }
        asm volatile("s_waitcnt vmcnt(0)" ::: "memory"); MK_BAR();
        { const float qs = __builtin_amdgcn_exp2f(lgb * (float)(128 - n));
#pragma unroll
          for (int ks = 0; ks < 8; ++ks) { const bf16x8 qf = scale8(qr[ks], qs);
#pragma unroll
              for (int d0 = 0; d0 < 4; ++d0) { const bf16x8 b = *(const LAS bf16x8*)(bufA + (128 * wh + 32 * d0) * 256 + KSWZ(r32, (16 * ks + 8 * hi) * 2)); o[d0] = __builtin_amdgcn_mfma_f32_32x32x16_bf16(qf, b, o[d0], 0, 0, 0); } } }
        MK_BAR();
#pragma unroll
        for (int r = 0; r < 16; ++r)
#pragma unroll
            for (int d = 0; d < 4; ++d) *(LAS float*)(lds + ((32 * wq + crow(r, hi)) * 256 + 128 * wh + 32 * d + r32) * 4) = o[d][r];
        MK_BAR();
        subln_gate_store(lds, P.ret_subln_g, 1.0f, rg + tokc * 2048 + head * 256, rv + tokc * 2048 + head * 256, 2048);
        MK_BAR();
    }
}

__global__ void __launch_bounds__(512) mega(Params P) {
    extern __shared__ __attribute__((aligned(16))) unsigned char shm[];
    LAS unsigned char* lds = (LAS unsigned char*)shm;
    cg::grid_group grid = cg::this_grid();
    volatile LAS unsigned* xst = (volatile LAS unsigned*)(lds + LDS_BYTES - 16);
    if (threadIdx.x == 0) { xst[0] = 0u; xst[1] = 0u; }
    __syncthreads();
    const XcdBarrier xb = xcd_barrier_post((unsigned*)(P.ws + OFF_BAR), xst);
    bf16_t* H = (bf16_t*)(P.ws + OFF_H); bf16_t* big = (bf16_t*)(P.ws + OFF_BIG);
    const bf16_t* WinDA = (const bf16_t*)(P.ws + OFF_WIN_DA); const bf16_t* WoutDA = (const bf16_t*)(P.ws + OFF_WOUT_DA);
    const bf16_t* WinRET = (const bf16_t*)(P.ws + OFF_WIN_RET); const bf16_t* WoutRET = (const bf16_t*)(P.ws + OFF_WOUT_RET);
    const float* tab = (const float*)(P.ws + OFF_TAB);
    prep_phase(P, lds);
    norm_to_bf16(P.x_prompt, P.norm_g, H, MR);
    grid.sync();
    bf16_t* D0 = (bf16_t*)(P.ws + OFF_D0); bf16_t* D1 = (bf16_t*)(P.ws + OFF_D1);
    for (int r = 0; r < NROUND; ++r) {
        const float* xin = r < 2 ? P.x_prompt + (size_t)r * MR * DM : P.x_sample;
        float* xio = P.out + (size_t)r * MR * DM;
        { EpiDA E; E.big = big; E.tcos = tab; E.tsin = tab + 262144; run_gemm(lds, H, WinDA, MR, 8192, 1024, E); }
        if (r > 0) { const float* xp = (r - 1) < 2 ? P.x_prompt + (size_t)(r - 1) * MR * DM : P.x_sample; comb2_norm_out(xp, D0, D1, P.final_norm_g, P.out + (size_t)(r - 1) * MR * DM, MR); }
        xcd_barrier(xb);
        attn_phase(P, lds);
        xcd_barrier(xb);
        { EpiDelta E; E.D = D0; run_gemm(lds, big, WoutDA, MR, 1024, 2048, E); }
        xcd_barrier(xb);
        comb_norm_to_bf16(xin, D0, nullptr, P.norm_g + DM, H, MR);
        xcd_barrier(xb);
        { EpiRET E; E.rq = (bf16_t*)(P.ws + OFF_RQ); E.rk = (bf16_t*)(P.ws + OFF_RK); E.rv = (bf16_t*)(P.ws + OFF_RV); E.rg = (bf16_t*)(P.ws + OFF_RG); E.tcos = tab + 2 * 262144; E.tsin = tab + 3 * 262144;
          run_gemm(lds, H, WinRET, MR, 6144, 1024, E); }
        xcd_barrier(xb);
        ret_chain_phase(P, lds);
        xcd_barrier(xb);
        ret_out_phase(P, lds);
        xcd_barrier(xb);
        { EpiDelta E; E.D = D1; run_gemm(lds, (const bf16_t*)(P.ws + OFF_RV), WoutRET, MR, 1024, 2048, E); }
        if (r + 1 < NROUND) { const float* xn = (r + 1) < 2 ? P.x_prompt + (size_t)(r + 1) * MR * DM : P.x_sample; norm_to_bf16(xn, P.norm_g, H, MR); }
        xcd_barrier(xb);
    }
    comb2_norm_out(P.x_sample, D0, D1, P.final_norm_g, P.out + (size_t)(NROUND - 1) * MR * DM, MR);
}
}

extern "C" void kernel_launch(void* const* d_in, const int* in_sizes, int n_in, void* d_out, int out_size, void* d_ws, size_t ws_size, hipStream_t stream) {
    static int grid_blocks = 0;
    if (!grid_blocks) {
        if (hipFuncSetAttribute((const void*)mk::mega, hipFuncAttributeMaxDynamicSharedMemorySize, (int)mk::LDS_BYTES) != hipSuccess) fprintf(stderr, "kernel_launch: LDS attribute failed\n");
        int dev = 0, cus = 0, per = 0; hipGetDevice(&dev); hipDeviceGetAttribute(&cus, hipDeviceAttributeMultiprocessorCount, dev);
        hipOccupancyMaxActiveBlocksPerMultiprocessor(&per, mk::mega, 512, mk::LDS_BYTES);
        if (per < 1) fprintf(stderr, "kernel_launch: occupancy query says %d blocks/CU\n", per);
        grid_blocks = cus > 0 ? cus : 256;
    }
    mk::Params p{};
    p.x_prompt = (const float*)d_in[0]; p.x_sample = (const float*)d_in[1]; p.norm_g = (const float*)d_in[2]; p.da_w_in = (const float*)d_in[3];
    p.lq1 = (const float*)d_in[4]; p.lk1 = (const float*)d_in[5]; p.lq2 = (const float*)d_in[6]; p.lk2 = (const float*)d_in[7];
    p.da_subln_g = (const float*)d_in[8]; p.da_w_out = (const float*)d_in[9]; p.ret_w_in = (const float*)d_in[10]; p.ret_decay_fwd = (const float*)d_in[11];
    p.ret_decay_bwd = (const float*)d_in[12]; p.ret_subln_g = (const float*)d_in[13]; p.ret_w_out = (const float*)d_in[14]; p.final_norm_g = (const float*)d_in[15];
    p.out = (float*)d_out; p.ws = (unsigned char*)d_ws;
    if (hipMemsetAsync((unsigned char*)d_ws + mk::OFF_BAR, 0, (size_t)XCD_BAR_WORDS * 4, stream) != hipSuccess) fprintf(stderr, "kernel_launch: barrier memset failed\n");
    void* args[] = {&p};
    hipError_t e = hipLaunchCooperativeKernel((void*)mk::mega, dim3(grid_blocks), dim3(512), args, (unsigned)mk::LDS_BYTES, stream);
    if (e != hipSuccess) fprintf(stderr, "kernel_launch: cooperative launch failed: %s (grid %d)\n", hipGetErrorString(e), grid_blocks);
}
```
